# Optimizing an MI355X kernel written in HIP

```python
import math
import jax, jax.numpy as jnp
from jax import lax
import numpy as np

D_MODEL = 1024
BATCH = 8
SEQ = 2048
DEPTH = 2

GRID_W = 64
CTX_LEN = 256
HEAD_DIM = 64
ROPE_THETA = 10000.0
Q_BLOCK = 128
EPS = 1e-6

B_WIDTH = D_MODEL // 4
B_GROUPS = 4
B_GROUP_DIM = B_WIDTH // B_GROUPS
POOL_WINDOWS = (2, 4, 8, 16)
A_WIDTH = D_MODEL - B_WIDTH
A_Q_HEADS = A_WIDTH // HEAD_DIM
A_KV_HEADS = A_Q_HEADS // 3
A_GROUP = A_Q_HEADS // A_KV_HEADS
A_KV_WIDTH = A_KV_HEADS * HEAD_DIM
A_IN_WIDTH = A_WIDTH + 2 * A_KV_WIDTH + B_WIDTH
D_CH = D_MODEL // 4
C_QK_DIM = HEAD_DIM
C_V_DIM = 2 * HEAD_DIM
C_WIDTH = D_MODEL - D_CH
C_HEADS = C_WIDTH // C_V_DIM
CONV_WIDTH = 31
C_IN_WIDTH = 3 * C_WIDTH + 2 * D_CH
FFN_HIDDEN = -(-8 * D_MODEL // (3 * 256)) * 256
ALPHA = (2.0 * DEPTH) ** 0.25
BETA = (8.0 * DEPTH) ** -0.25

F32 = jnp.float32

kernel_name = 'hybrid_diffusion_gqa_pool_diffattn_conformer'


def layer_norm(x, g, b):
    xf = x.astype(F32)
    mu = jnp.mean(xf, axis=-1, keepdims=True)
    var = jnp.mean(jnp.square(xf - mu), axis=-1, keepdims=True)
    return ((xf - mu) * lax.rsqrt(var + EPS) * g.astype(F32) + b.astype(F32)).astype(x.dtype)


def rms_norm(x, g):
    xf = x.astype(F32)
    return (xf * lax.rsqrt(jnp.mean(jnp.square(xf), axis=-1, keepdims=True) + EPS) * g.astype(F32)).astype(x.dtype)


def axial_rope_tables(n_tokens):
    rows = n_tokens // GRID_W
    row = jnp.repeat(jnp.arange(rows, dtype=F32), GRID_W)
    col = jnp.tile(jnp.arange(GRID_W, dtype=F32), rows)
    axis_dim = HEAD_DIM // 2
    freqs = ROPE_THETA ** (-jnp.arange(0, axis_dim, 2, dtype=F32) / axis_dim)
    ang = jnp.concatenate([row[:, None] * freqs, col[:, None] * freqs], axis=-1)
    return jnp.cos(ang), jnp.sin(ang)


def apply_axial_rope(x, cos, sin):
    q = HEAD_DIM // 4
    xf = x.astype(F32)

    def rot(xa, c, s):
        x1, x2 = xa[..., :q], xa[..., q:]
        return jnp.concatenate([x1 * c - x2 * s, x2 * c + x1 * s], axis=-1)

    out = jnp.concatenate([rot(xf[..., :2 * q], cos[:, :q], sin[:, :q]),
                           rot(xf[..., 2 * q:], cos[:, q:], sin[:, q:])], axis=-1)
    return out.astype(x.dtype)


def map_query_blocks(fn, q):
    t = q.shape[-2]
    nb = t // Q_BLOCK
    qb = jnp.moveaxis(q.reshape(q.shape[:-2] + (nb, Q_BLOCK, q.shape[-1])), -3, 0)
    out = jnp.moveaxis(lax.map(fn, qb), 0, -3)
    return out.reshape(out.shape[:-3] + (t, out.shape[-1]))


def gqa_attend(q, k, v):
    s = jnp.einsum('bkgqd,bksd->bkgqs', q, k, preferred_element_type=F32) * (HEAD_DIM ** -0.5)
    p = jax.nn.softmax(s, axis=-1)
    return jnp.einsum('bkgqs,bksd->bkgqd', p.astype(v.dtype), v)


def diff_attend(q, k, v, lam):
    s = jnp.einsum('bhiqd,bhisd->bhiqs', q, k, preferred_element_type=F32) * (C_QK_DIM ** -0.5)
    p = jax.nn.softmax(s, axis=-1)
    a = p[:, :, 0] - lam * p[:, :, 1]
    return jnp.einsum('bhqs,bhsd->bhqd', a.astype(v.dtype), v)


def centred_window_mean(x, w):
    t_len = x.shape[1]
    cs = jnp.pad(jnp.cumsum(x.astype(F32), axis=1), ((0, 0), (1, 0), (0, 0)))
    t = jnp.arange(t_len)
    lo = jnp.clip(t - w // 2, 0, t_len)
    hi = jnp.clip(t + (w - 1 - w // 2) + 1, 0, t_len)
    s = jnp.take(cs, hi, axis=1) - jnp.take(cs, lo, axis=1)
    return (s / (hi - lo).astype(F32)[None, :, None]).astype(x.dtype)


def pool_mixer(u, w_pool, pool_scale):
    bsz, n, _ = u.shape
    ug = u.reshape(bsz, n, B_GROUPS, B_GROUP_DIM)
    pooled = jnp.stack([centred_window_mean(ug[:, :, g], w) - ug[:, :, g]
                        for g, w in enumerate(POOL_WINDOWS)], axis=2)
    mixed = jnp.einsum('bngc,gcd->bngd', pooled, w_pool)
    return mixed.reshape(bsz, n, B_WIDTH) * pool_scale


def conformer_conv(u, conv_w, conv_b, ln_g, ln_b):
    a, g = jnp.split(u, 2, axis=-1)
    z = a * jax.nn.sigmoid(g)
    z = lax.conv_general_dilated(z, conv_w[:, None, :].astype(z.dtype), window_strides=(1,),
                                 padding=[(CONV_WIDTH // 2, CONV_WIDTH // 2)],
                                 dimension_numbers=('NWC', 'WIO', 'NWC'),
                                 feature_group_count=D_CH) + conv_b
    return jax.nn.silu(layer_norm(z, ln_g, ln_b))


def swiglu(h, w_in, w_out):
    a, g = jnp.split(h @ w_in, 2, axis=-1)
    return (jax.nn.silu(g) * a) @ w_out


def mixer_ab(h, hc, w_in, q_gain, k_gain, w_pool, pool_scale, w_out, cos, sin, with_ctx_out):
    bsz, n_lat, _ = h.shape
    n_ctx = hc.shape[1]
    n = n_ctx + n_lat
    p = jnp.concatenate([hc, h], axis=1) @ w_in
    q, k, v, u = jnp.split(p, [A_WIDTH, A_WIDTH + A_KV_WIDTH, A_WIDTH + 2 * A_KV_WIDTH], axis=-1)
    q = rms_norm(q.reshape(bsz, n, A_KV_HEADS, A_GROUP, HEAD_DIM), q_gain).transpose(0, 2, 3, 1, 4)
    k = rms_norm(k.reshape(bsz, n, A_KV_HEADS, HEAD_DIM), k_gain).transpose(0, 2, 1, 3)
    v = v.reshape(bsz, n, A_KV_HEADS, HEAD_DIM).transpose(0, 2, 1, 3)
    k_all = jnp.concatenate([k[..., :n_ctx, :], apply_axial_rope(k[..., n_ctx:, :], cos, sin)], axis=-2)
    q_lat = apply_axial_rope(q[..., n_ctx:, :], cos, sin)
    o_lat = map_query_blocks(lambda qb: gqa_attend(qb, k_all, v), q_lat)

    def finish(o, uu):
        o = o.transpose(0, 3, 1, 2, 4).reshape(o.shape[0], o.shape[3], A_WIDTH)
        return jnp.concatenate([o, pool_mixer(uu, w_pool, pool_scale)], axis=-1) @ w_out

    y = finish(o_lat, u[:, n_ctx:])
    yc = None
    if with_ctx_out:
        o_ctx = gqa_attend(q[..., :n_ctx, :], k[..., :n_ctx, :], v[:, :, :n_ctx])
        yc = finish(o_ctx, u[:, :n_ctx])
    return y, yc


def mixer_cd(h, hc, w_in, lq1, lk1, lq2, lk2, subln_gain, conv_w, conv_b, conv_ln_g, conv_ln_b,
             w_out, cos, sin, lam_init, with_ctx_out):
    bsz, n_lat, _ = h.shape
    n_ctx = hc.shape[1]
    n = n_ctx + n_lat
    p = jnp.concatenate([hc, h], axis=1) @ w_in
    q, k, v, u = jnp.split(p, [C_WIDTH, 2 * C_WIDTH, 3 * C_WIDTH], axis=-1)
    q = q.reshape(bsz, n, C_HEADS, 2, C_QK_DIM).transpose(0, 2, 3, 1, 4)
    k = k.reshape(bsz, n, C_HEADS, 2, C_QK_DIM).transpose(0, 2, 3, 1, 4)
    v = v.reshape(bsz, n, C_HEADS, C_V_DIM).transpose(0, 2, 1, 3)
    lam = (jnp.exp(jnp.sum(lq1.astype(F32) * lk1.astype(F32)))
           - jnp.exp(jnp.sum(lq2.astype(F32) * lk2.astype(F32))) + lam_init)
    k_all = jnp.concatenate([k[..., :n_ctx, :], apply_axial_rope(k[..., n_ctx:, :], cos, sin)], axis=-2)
    q_lat = apply_axial_rope(q[..., n_ctx:, :], cos, sin)
    o_lat = map_query_blocks(lambda qb: diff_attend(qb, k_all, v, lam), q_lat)

    def finish(o, uu):
        o = rms_norm(o, subln_gain) * (1.0 - lam_init)
        o = o.transpose(0, 2, 1, 3).reshape(o.shape[0], o.shape[2], C_WIDTH)
        conv = conformer_conv(uu, conv_w, conv_b, conv_ln_g, conv_ln_b)
        return jnp.concatenate([o, conv], axis=-1) @ w_out

    y = finish(o_lat, u[:, n_ctx:])
    yc = None
    if with_ctx_out:
        o_ctx = diff_attend(q[..., :n_ctx, :], k[..., :n_ctx, :], v[:, :, :n_ctx], lam)
        yc = finish(o_ctx, u[:, :n_ctx])
    return y, yc


def setup_inputs(seed: int = 0) -> dict:
    key = jax.random.key(seed)
    ks = iter(jax.random.split(key, 32))
    n_even = (DEPTH + 1) // 2
    n_odd = DEPTH // 2

    def nrm(shape, scale):
        return jax.random.normal(next(ks), shape, F32) * scale

    def gain(shape):
        return 1.0 + nrm(shape, 0.05)

    return {
        'x': nrm((BATCH, SEQ, D_MODEL), 1.0),
        'c': nrm((BATCH, D_MODEL), 1.0),
        'ctx': nrm((BATCH, CTX_LEN, D_MODEL), 1.0),
        'c_ctx': nrm((D_MODEL,), 1.0),
        'ab_w_in': nrm((n_even, D_MODEL, A_IN_WIDTH), D_MODEL ** -0.5),
        'ab_q_gain': gain((n_even, HEAD_DIM)),
        'ab_k_gain': gain((n_even, HEAD_DIM)),
        'ab_w_pool': nrm((n_even, B_GROUPS, B_GROUP_DIM, B_GROUP_DIM), B_GROUP_DIM ** -0.5),
        'ab_pool_scale': gain((n_even, B_WIDTH)),
        'ab_w_out': nrm((n_even, D_MODEL, D_MODEL), BETA * D_MODEL ** -0.5),
        'cd_w_in': nrm((n_odd, D_MODEL, C_IN_WIDTH), D_MODEL ** -0.5),
        'cd_lambda_q1': nrm((n_odd, C_QK_DIM), 0.1),
        'cd_lambda_k1': nrm((n_odd, C_QK_DIM), 0.1),
        'cd_lambda_q2': nrm((n_odd, C_QK_DIM), 0.1),
        'cd_lambda_k2': nrm((n_odd, C_QK_DIM), 0.1),
        'cd_subln_gain': gain((n_odd, C_V_DIM)),
        'cd_conv_w': nrm((n_odd, CONV_WIDTH, D_CH), CONV_WIDTH ** -0.5),
        'cd_conv_b': nrm((n_odd, D_CH), 0.02),
        'cd_conv_ln_g': gain((n_odd, D_CH)),
        'cd_conv_ln_b': nrm((n_odd, D_CH), 0.02),
        'cd_w_out': nrm((n_odd, D_MODEL, D_MODEL), BETA * D_MODEL ** -0.5),
        'ada_w': nrm((DEPTH, D_MODEL, 6 * D_MODEL), 0.5 * D_MODEL ** -0.5),
        'ada_b': nrm((DEPTH, 6 * D_MODEL), 0.02),
        'ln1_g': gain((DEPTH, D_MODEL)),
        'ln1_b': nrm((DEPTH, D_MODEL), 0.02),
        'ln2_g': gain((DEPTH, D_MODEL)),
        'ln2_b': nrm((DEPTH, D_MODEL), 0.02),
        'ffn_w_in': nrm((DEPTH, D_MODEL, 2 * FFN_HIDDEN), D_MODEL ** -0.5),
        'ffn_w_out': nrm((DEPTH, FFN_HIDDEN, D_MODEL), BETA * FFN_HIDDEN ** -0.5),
    }


def reference(x, c, ctx, c_ctx, ab_w_in, ab_q_gain, ab_k_gain, ab_w_pool, ab_pool_scale, ab_w_out,
              cd_w_in, cd_lambda_q1, cd_lambda_k1, cd_lambda_q2, cd_lambda_k2, cd_subln_gain,
              cd_conv_w, cd_conv_b, cd_conv_ln_g, cd_conv_ln_b, cd_w_out,
              ada_w, ada_b, ln1_g, ln1_b, ln2_g, ln2_b, ffn_w_in, ffn_w_out):
    cos, sin = axial_rope_tables(x.shape[1])
    xc = ctx
    for l in range(DEPTH):
        with_ctx_out = l < DEPTH - 1
        mod = (jax.nn.silu(c) @ ada_w[l] + ada_b[l])[:, None, :]
        mod_c = (jax.nn.silu(c_ctx) @ ada_w[l] + ada_b[l])[None, None, :]
        sh1, sc1, g1, sh2, sc2, g2 = jnp.split(mod, 6, axis=-1)
        csh1, csc1, cg1, csh2, csc2, cg2 = jnp.split(mod_c, 6, axis=-1)
        h = x * (1.0 + sc1) + sh1
        hc = xc * (1.0 + csc1) + csh1
        i = l // 2
        if l % 2 == 0:
            y, yc = mixer_ab(h, hc, ab_w_in[i], ab_q_gain[i], ab_k_gain[i], ab_w_pool[i], ab_pool_scale[i],
                             ab_w_out[i], cos, sin, with_ctx_out)
        else:
            lam_init = 0.8 - 0.6 * math.exp(-0.3 * l)
            y, yc = mixer_cd(h, hc, cd_w_in[i], cd_lambda_q1[i], cd_lambda_k1[i], cd_lambda_q2[i], cd_lambda_k2[i],
                             cd_subln_gain[i], cd_conv_w[i], cd_conv_b[i], cd_conv_ln_g[i], cd_conv_ln_b[i],
                             cd_w_out[i], cos, sin, lam_init, with_ctx_out)
        x = layer_norm(ALPHA * x + g1 * y, ln1_g[l], ln1_b[l])
        x = layer_norm(ALPHA * x + g2 * swiglu(x * (1.0 + sc2) + sh2, ffn_w_in[l], ffn_w_out[l]), ln2_g[l], ln2_b[l])
        if with_ctx_out:
            xc = layer_norm(ALPHA * xc + cg1 * yc, ln1_g[l], ln1_b[l])
            xc = layer_norm(ALPHA * xc + cg2 * swiglu(xc * (1.0 + csc2) + csh2, ffn_w_in[l], ffn_w_out[l]),
                            ln2_g[l], ln2_b[l])
    return x
```

```cpp
#include <hip/hip_runtime.h>
#include <cstdio>
#include <cstdint>
#include <cmath>
#include <cstring>

constexpr int D = 1024, NB = 8, SEQ = 2048, CTXL = 256, TOK = SEQ + CTXL, R = NB * TOK;
constexpr int FF = 2816, HD = 64;
constexpr int P0 = 1536;
constexpr int P1 = 2560;
constexpr int CIN1 = 2816;
constexpr float ALPHA = 1.4142135623730951f, LN_EPS = 1e-6f;
constexpr float QSCALE = 0.125f * 1.4426950408889634f;
constexpr float LAM_INIT = 0.35550906758f;
constexpr int MODW = 6 * D;

constexpr size_t MiB = 1u << 20;
constexpr size_t WS_CTL = 0, WS_MOD = 1 * MiB, WS_ROPE = WS_MOD + 2 * 9 * MODW * 4;
constexpr size_t WS_XC = 48 * MiB, WS_BUFA = 56 * MiB, WS_BUFB = 92 * MiB, WS_BIG = 128 * MiB, WS_END = 227 * MiB;
static_assert(WS_ROPE + 2 * 64 * 16 * 4 <= 2 * MiB, "ws map");

typedef unsigned short bf16;
__device__ __forceinline__ unsigned f2bf(float f) { unsigned u = __builtin_bit_cast(unsigned, f); return (u + 0x7fffu + ((u >> 16) & 1u)) >> 16; }
__device__ __forceinline__ float bf2f(unsigned short h) { return __builtin_bit_cast(float, (unsigned)h << 16); }
__device__ __forceinline__ float silu_f(float x) { return x / (1.f + __expf(-x)); }
__device__ __forceinline__ float sigmoid_f(float x) { return 1.f / (1.f + __expf(-x)); }

struct Ptrs {
    const float *x, *c, *ctx, *c_ctx, *ab_w_in, *ab_q_gain, *ab_k_gain, *ab_w_pool, *ab_pool_scale, *ab_w_out,
        *cd_w_in, *lq1, *lk1, *lq2, *lk2, *subln, *conv_w, *conv_b, *conv_ln_g, *conv_ln_b, *cd_w_out,
        *ada_w, *ada_b, *ln1_g, *ln1_b, *ln2_g, *ln2_b, *ffn_w_in, *ffn_w_out;
    float* out; unsigned char* ws;
};
__device__ __forceinline__ float* res_row(const Ptrs& p, int r) {
    const int b = r / TOK, tp = r % TOK;
    return tp < CTXL ? (float*)(p.ws + WS_XC) + (size_t)(b * CTXL + tp) * D : p.out + (size_t)(b * SEQ + tp - CTXL) * D;
}
__device__ __forceinline__ const float* in_row(const Ptrs& p, int r) {
    const int b = r / TOK, tp = r % TOK;
    return tp < CTXL ? p.ctx + (size_t)(b * CTXL + tp) * D : p.x + (size_t)(b * SEQ + tp - CTXL) * D;
}
__device__ __forceinline__ const float* mod_vec(const Ptrs& p, int layer, int r) {
    const int b = r / TOK, tp = r % TOK;
    return (const float*)(p.ws + WS_MOD) + (size_t)(layer * 9 + (tp < CTXL ? 8 : b)) * MODW;
}

__global__ void n_prep(Ptrs p) {
    const int gid = blockIdx.x * blockDim.x + threadIdx.x;
    if (gid < 2 * 9 * MODW) {
        const int l = gid / (9 * MODW), v = (gid / MODW) % 9, j = gid % MODW;
        const float* cv = v < 8 ? p.c + v * D : p.c_ctx; const float* W = p.ada_w + (size_t)l * D * MODW;
        float acc = 0.f;
        for (int k = 0; k < D; ++k) acc += silu_f(cv[k]) * W[(size_t)k * MODW + j];
        ((float*)(p.ws + WS_MOD))[gid] = acc + p.ada_b[l * MODW + j];
    } else if (gid < 2 * 9 * MODW + 1024) {
        const int e = gid - 2 * 9 * MODW, pos = e / 16, i = e % 16;
        const double fr = pow(10000.0, -(2.0 * i) / 32.0), ang = (double)pos * fr;
        float* rope = (float*)(p.ws + WS_ROPE); rope[e] = (float)cos(ang); rope[1024 + e] = (float)sin(ang);
    }
}

__device__ __forceinline__ float wave_sum(float v) {
#pragma unroll
    for (int o = 1; o < 64; o <<= 1) v += __shfl_xor(v, o);
    return v;
}
__device__ __forceinline__ void row_pass(const Ptrs& p, int r, int lane, int mode, const float* lng, const float* lnb, int hlayer, int hoff) {
    float4 v[4];
    const float4* src = (const float4*)(mode == 0 ? in_row(p, r) : res_row(p, r));
#pragma unroll
    for (int j = 0; j < 4; ++j) v[j] = src[lane + 64 * j];
    if (mode == 1) {
        float s = 0.f;
#pragma unroll
        for (int j = 0; j < 4; ++j) s += (v[j].x + v[j].y) + (v[j].z + v[j].w);
        const float mean = wave_sum(s) * (1.f / D); float q = 0.f;
#pragma unroll
        for (int j = 0; j < 4; ++j) { v[j].x -= mean; v[j].y -= mean; v[j].z -= mean; v[j].w -= mean; q += (v[j].x * v[j].x + v[j].y * v[j].y) + (v[j].z * v[j].z + v[j].w * v[j].w); }
        const float rstd = 1.f / sqrtf(wave_sum(q) * (1.f / D) + LN_EPS);
        float4* dst = (float4*)res_row(p, r);
#pragma unroll
        for (int j = 0; j < 4; ++j) { const float4 g = ((const float4*)lng)[lane + 64 * j], b = ((const float4*)lnb)[lane + 64 * j];
            v[j].x = v[j].x * rstd * g.x + b.x; v[j].y = v[j].y * rstd * g.y + b.y; v[j].z = v[j].z * rstd * g.z + b.z; v[j].w = v[j].w * rstd * g.w + b.w; dst[lane + 64 * j] = v[j]; }
    }
    if (hoff >= 0) {
        const float* mv = mod_vec(p, hlayer, r); const float4* sh = (const float4*)(mv + hoff); const float4* sc = (const float4*)(mv + hoff + D);
        uint2* dst = (uint2*)((bf16*)(p.ws + WS_BUFA) + (size_t)r * D);
#pragma unroll
        for (int j = 0; j < 4; ++j) { const float4 a = sh[lane + 64 * j], s = sc[lane + 64 * j];
            const float h0 = v[j].x * (1.f + s.x) + a.x, h1 = v[j].y * (1.f + s.y) + a.y, h2 = v[j].z * (1.f + s.z) + a.z, h3 = v[j].w * (1.f + s.w) + a.w;
            dst[lane + 64 * j] = make_uint2(f2bf(h0) | (f2bf(h1) << 16), f2bf(h2) | (f2bf(h3) << 16)); }
    }
}
__global__ __launch_bounds__(256) void n_rowpass(Ptrs p, int mode, int latent_only, const float* lng, const float* lnb, int hlayer, int hoff) {
    const int gw = (blockIdx.x * 256 + threadIdx.x) >> 6, lane = threadIdx.x & 63, nw = (gridDim.x * 256) >> 6;
    const int nrows = latent_only ? NB * SEQ : R;
    for (int i = gw; i < nrows; i += nw) { const int r = latent_only ? (i / SEQ) * TOK + CTXL + i % SEQ : i; row_pass(p, r, lane, mode, lng, lnb, hlayer, hoff); }
}

enum { EPI_IN0 = 0, EPI_IN1 = 1, EPI_RES = 2, EPI_FFN = 3 };
struct NG { const bf16* A; const float* W; bf16* O; int K, ldw, rowmode  , epi, layer, tn0  , resid_in_is_input, gate_off; };
static NG mk(const bf16* A, int K, const float* W, int ldw, int rowmode, int epi, int layer, int tn0, int rin, int gate_off, bf16* O) {
    NG g; memset(&g, 0, sizeof(g)); g.A = A; g.W = W; g.O = O; g.K = K; g.ldw = ldw; g.rowmode = rowmode; g.epi = epi; g.layer = layer; g.tn0 = tn0; g.resid_in_is_input = rin; g.gate_off = gate_off; return g; }
__global__ __launch_bounds__(256) void n_gemm(Ptrs p, NG g) {
    __shared__ float As[16][68]; __shared__ float Ws[16][64]; __shared__ float Ws2[16][64]; __shared__ float Out[64][65]; __shared__ float Out2[64][65];
    const int tid = threadIdx.x, ty = tid >> 4, tx = tid & 15, tm = blockIdx.y, tn = blockIdx.x + g.tn0;
    int row0;
    if (g.rowmode == 0) row0 = tm * 64; else if (g.rowmode == 1) row0 = (tm / 32) * TOK + CTXL + (tm % 32) * 64; else row0 = (tm / 4) * TOK + (tm % 4) * 64;
    int c0 = tn * 64, c1 = -1;
    if (g.epi == EPI_FFN) { c1 = FF + tn * 64; }
    if (g.epi == EPI_IN1 && tn >= 36) { c0 = 2304 + (tn - 36) * 64; c1 = 2560 + (tn - 36) * 64; }
    const bool dual = c1 >= 0;
    float acc[4][4] = {}, acc2[4][4] = {};
    for (int k0 = 0; k0 < g.K; k0 += 16) {
        { const int rr = tid >> 2, kk = (tid & 3) * 4; const uint2 a = *(const uint2*)(g.A + (size_t)(row0 + rr) * g.K + k0 + kk);
          As[kk + 0][rr] = bf2f(a.x & 0xffff); As[kk + 1][rr] = bf2f(a.x >> 16); As[kk + 2][rr] = bf2f(a.y & 0xffff); As[kk + 3][rr] = bf2f(a.y >> 16); }
        { const int kk = tid >> 4, cc = (tid & 15) * 4; *(float4*)&Ws[kk][cc] = *(const float4*)(g.W + (size_t)(k0 + kk) * g.ldw + c0 + cc);
          if (dual) *(float4*)&Ws2[kk][cc] = *(const float4*)(g.W + (size_t)(k0 + kk) * g.ldw + c1 + cc); }
        __syncthreads();
#pragma unroll
        for (int kk = 0; kk < 16; ++kk) {
            float a[4], w[4], w2[4];
#pragma unroll
            for (int i = 0; i < 4; ++i) { a[i] = As[kk][ty * 4 + i]; w[i] = Ws[kk][tx * 4 + i]; w2[i] = dual ? Ws2[kk][tx * 4 + i] : 0.f; }
#pragma unroll
            for (int i = 0; i < 4; ++i)
#pragma unroll
                for (int j = 0; j < 4; ++j) { acc[i][j] += a[i] * w[j]; acc2[i][j] += a[i] * w2[j]; }
        }
        __syncthreads();
    }
#pragma unroll
    for (int i = 0; i < 4; ++i)
#pragma unroll
        for (int j = 0; j < 4; ++j) { Out[ty * 4 + i][tx * 4 + j] = acc[i][j]; Out2[ty * 4 + i][tx * 4 + j] = acc2[i][j]; }
    __syncthreads();
    const float* rope = (const float*)(p.ws + WS_ROPE);
    if (g.epi == EPI_RES) {
        for (int e = tid; e < 64 * 64; e += 256) { const int rr = e >> 6, cc = e & 63, r = row0 + rr, c = c0 + cc;
            const float xin = g.resid_in_is_input ? in_row(p, r)[c] : res_row(p, r)[c];
            res_row(p, r)[c] = ALPHA * xin + mod_vec(p, g.layer, r)[g.gate_off + c] * Out[rr][cc]; }
    } else if (g.epi == EPI_FFN) {
        for (int e = tid; e < 64 * 64; e += 256) { const int rr = e >> 6, cc = e & 63;
            g.O[(size_t)(row0 + rr) * FF + c0 + cc] = (bf16)f2bf(silu_f(Out2[rr][cc]) * Out[rr][cc]); }
    } else if (dual) {
        for (int e = tid; e < 64 * 64; e += 256) { const int rr = e >> 6, cc = e & 63;
            g.O[(size_t)(row0 + rr) * P1 + 2304 + (tn - 36) * 64 + cc] = (bf16)f2bf(Out[rr][cc] * sigmoid_f(Out2[rr][cc])); }
    } else if (tid < 64) {
        const int rr = tid, r = row0 + rr, tp = r % TOK; const bool lat = tp >= CTXL; const int t = tp - CTXL;
        int kind; const float* gain = nullptr; int pitch;
        if (g.epi == EPI_IN0) { pitch = P0; kind = tn < 12 ? 0 : (tn < 16 ? 1 : 2); gain = tn < 12 ? p.ab_q_gain : p.ab_k_gain; }
        else { pitch = P1; kind = tn < 12 ? 0 : (tn < 24 ? 1 : 2); }
        float v[64];
#pragma unroll
        for (int d = 0; d < 64; ++d) v[d] = Out[rr][d];
        if (kind < 2) {
            if (g.epi == EPI_IN0) { float ss = 0.f;
#pragma unroll
                for (int d = 0; d < 64; ++d) ss += v[d] * v[d];
                const float rs = 1.f / sqrtf(ss * (1.f / 64.f) + LN_EPS);
#pragma unroll
                for (int d = 0; d < 64; ++d) v[d] = v[d] * rs * gain[d]; }
            if (lat) {
                const int prow = t / 64, pcol = t % 64;
#pragma unroll
                for (int i = 0; i < 16; ++i) {
                    { const float c = rope[prow * 16 + i], s = rope[1024 + prow * 16 + i], x1 = v[i], x2 = v[16 + i]; v[i] = x1 * c - x2 * s; v[16 + i] = x2 * c + x1 * s; }
                    { const float c = rope[pcol * 16 + i], s = rope[1024 + pcol * 16 + i], x1 = v[32 + i], x2 = v[48 + i]; v[32 + i] = x1 * c - x2 * s; v[48 + i] = x2 * c + x1 * s; }
                }
            }
            if (kind == 0) {
#pragma unroll
                for (int d = 0; d < 64; ++d) v[d] *= QSCALE; }
        }
        bf16* o = g.O + (size_t)r * pitch + tn * 64;
#pragma unroll
        for (int d = 0; d < 64; ++d) o[d] = (bf16)f2bf(v[d]);
    }
}

__global__ __launch_bounds__(256) void n_attn0(Ptrs p) {
    const int b = blockIdx.z, h = blockIdx.y, ch = blockIdx.x, kvh = h / 3;
    const bf16* QKV = (const bf16*)(p.ws + WS_BIG);
    const int r = b * TOK + ch * 256 + threadIdx.x, nkeys = ch == 0 ? CTXL : TOK;
    float q[64], o[64];
    { const bf16* qp = QKV + (size_t)r * P0 + h * 64;
#pragma unroll
      for (int d = 0; d < 64; ++d) { q[d] = bf2f(qp[d]); o[d] = 0.f; } }
    float m = -1e30f, l = 0.f;
    for (int j = 0; j < nkeys; ++j) {
        const bf16* kp = QKV + (size_t)(b * TOK + j) * P0 + 768 + kvh * 64; const bf16* vp = kp + 256;
        float s = 0.f;
#pragma unroll
        for (int d = 0; d < 64; ++d) s += q[d] * bf2f(kp[d]);
        const float mn = fmaxf(m, s), a = exp2f(m - mn), pp = exp2f(s - mn);
        l = l * a + pp; m = mn;
#pragma unroll
        for (int d = 0; d < 64; ++d) o[d] = o[d] * a + pp * bf2f(vp[d]);
    }
    bf16* op = (bf16*)(p.ws + WS_BUFB) + (size_t)r * D + h * 64; const float il = 1.f / l;
#pragma unroll
    for (int d = 0; d < 64; ++d) op[d] = (bf16)f2bf(o[d] * il);
}
__global__ __launch_bounds__(256) void n_pool(Ptrs p) {
    __shared__ float pooled[256];
    const int r = blockIdx.x, tp = r % TOK, c = threadIdx.x, g = c >> 6; const bool lat = tp >= CTXL;
    const int t = lat ? tp - CTXL : tp, n = lat ? SEQ : CTXL, rbase = r - t;
    const bf16* U = (const bf16*)(p.ws + WS_BIG) + 1280;
    const int w = 2 << g, lo = max(t - w / 2, 0), hi = min(t + w - w / 2, n);
    float s = 0.f;
    for (int j = lo; j < hi; ++j) s += bf2f(U[(size_t)(rbase + j) * P0 + c]);
    pooled[c] = s / (float)(hi - lo) - bf2f(U[(size_t)r * P0 + c]);
    __syncthreads();
    const int d = c & 63; const float* W = p.ab_w_pool + (size_t)g * 64 * 64;
    float acc = 0.f;
    for (int cc = 0; cc < 64; ++cc) acc += pooled[g * 64 + cc] * W[cc * 64 + d];
    ((bf16*)(p.ws + WS_BUFB))[(size_t)r * D + 768 + c] = (bf16)f2bf(acc * p.ab_pool_scale[c]);
}
__global__ __launch_bounds__(256) void n_attn1(Ptrs p) {
    __shared__ float lam_s;
    const int b = blockIdx.z, h = blockIdx.y, qi = threadIdx.x >> 2, qt = threadIdx.x & 3;
    if (threadIdx.x == 0) { float a = 0.f, c = 0.f; for (int i = 0; i < 64; ++i) { a += p.lq1[i] * p.lk1[i]; c += p.lq2[i] * p.lk2[i]; } lam_s = expf(a) - expf(c) + LAM_INIT; }
    __syncthreads();
    const float lam = lam_s;
    const bf16* QKV = (const bf16*)(p.ws + WS_BIG);
    const int r = b * TOK + CTXL + blockIdx.x * 64 + qi;
    float on[2][32];
#pragma unroll
    for (int comp = 0; comp < 2; ++comp) {
        float q[64], o[32];
        { const bf16* qp = QKV + (size_t)r * P1 + (h * 2 + comp) * 64;
#pragma unroll
          for (int d = 0; d < 64; ++d) q[d] = bf2f(qp[d]);
#pragma unroll
          for (int d = 0; d < 32; ++d) o[d] = 0.f; }
        float m = -1e30f, l = 0.f;
        for (int j = 0; j < TOK; ++j) {
            const bf16* kp = QKV + (size_t)(b * TOK + j) * P1 + 768 + (h * 2 + comp) * 64; const bf16* vp = QKV + (size_t)(b * TOK + j) * P1 + 1536 + h * 128 + qt * 32;
            float s = 0.f;
#pragma unroll
            for (int d = 0; d < 64; ++d) s += q[d] * bf2f(kp[d]);
            const float mn = fmaxf(m, s), a = exp2f(m - mn), pp = exp2f(s - mn);
            l = l * a + pp; m = mn;
#pragma unroll
            for (int d = 0; d < 32; ++d) o[d] = o[d] * a + pp * bf2f(vp[d]);
        }
        const float il = 1.f / l;
#pragma unroll
        for (int d = 0; d < 32; ++d) on[comp][d] = o[d] * il;
    }
    float ss = 0.f, df[32];
#pragma unroll
    for (int d = 0; d < 32; ++d) { df[d] = on[0][d] - lam * on[1][d]; ss += df[d] * df[d]; }
    ss += __shfl_xor(ss, 1); ss += __shfl_xor(ss, 2);
    const float rs = 1.f / sqrtf(ss * (1.f / 128.f) + LN_EPS) * (1.f - LAM_INIT);
    bf16* op = (bf16*)(p.ws + WS_BUFB) + (size_t)r * D + h * 128 + qt * 32;
#pragma unroll
    for (int d = 0; d < 32; ++d) op[d] = (bf16)f2bf(df[d] * rs * p.subln[qt * 32 + d]);
}
__global__ __launch_bounds__(256) void n_conv(Ptrs p) {
    __shared__ float red[8];
    const int b = blockIdx.x / SEQ, t = blockIdx.x % SEQ, c = threadIdx.x, r = b * TOK + CTXL + t;
    const bf16* Z = (const bf16*)(p.ws + WS_BIG) + 2304;
    float acc = p.conv_b[c];
    for (int j = 0; j < 31; ++j) { const int tt = t + j - 15; if (tt >= 0 && tt < SEQ) acc += bf2f(Z[(size_t)(b * TOK + CTXL + tt) * P1 + c]) * p.conv_w[j * 256 + c]; }
    float s = wave_sum(acc); if ((c & 63) == 0) red[c >> 6] = s; __syncthreads();
    const float mean = (red[0] + red[1] + red[2] + red[3]) * (1.f / 256.f); const float dv = acc - mean;
    float q = wave_sum(dv * dv); if ((c & 63) == 0) red[4 + (c >> 6)] = q; __syncthreads();
    const float rstd = 1.f / sqrtf((red[4] + red[5] + red[6] + red[7]) * (1.f / 256.f) + LN_EPS);
    const float y = dv * rstd * p.conv_ln_g[c] + p.conv_ln_b[c];
    ((bf16*)(p.ws + WS_BUFB))[(size_t)r * D + 768 + c] = (bf16)f2bf(silu_f(y));
}

extern "C" void kernel_launch(void* const* d_in, const int* in_sizes, int n_in, void* d_out, int out_size, void* d_ws, size_t ws_size, hipStream_t stream) {
    if (n_in != 29 || in_sizes[0] != NB * SEQ * D || out_size != NB * SEQ * D || ws_size < WS_END) { fprintf(stderr, "kernel_launch: unexpected shapes (n_in %d, ws %zu)\n", n_in, ws_size); return; }
    Ptrs p{};
    const float** f = (const float**)&p;
    for (int i = 0; i < 29; ++i) f[i] = (const float*)d_in[i];
    p.out = (float*)d_out; p.ws = (unsigned char*)d_ws;
    bf16* BUFA = (bf16*)(p.ws + WS_BUFA); bf16* BUFB = (bf16*)(p.ws + WS_BUFB); bf16* BIG = (bf16*)(p.ws + WS_BIG);
    n_prep<<<(2 * 9 * MODW + 1024 + 255) / 256, 256, 0, stream>>>(p);
    n_rowpass<<<1024, 256, 0, stream>>>(p, 0, 0, nullptr, nullptr, 0, 0);
    { NG g = mk(BUFA, D, p.ab_w_in, P0, 0, EPI_IN0, 0, 0, 0, 0, BIG); n_gemm<<<dim3(24, R / 64), 256, 0, stream>>>(p, g); }
    n_attn0<<<dim3(9, 12, NB), 256, 0, stream>>>(p);
    n_pool<<<R, 256, 0, stream>>>(p);
    { NG g = mk(BUFB, D, p.ab_w_out, D, 0, EPI_RES, 0, 0, 1, 2048, nullptr); n_gemm<<<dim3(16, R / 64), 256, 0, stream>>>(p, g); }
    n_rowpass<<<1024, 256, 0, stream>>>(p, 1, 0, p.ln1_g, p.ln1_b, 0, 3072);
    { NG g = mk(BUFA, D, p.ffn_w_in, 2 * FF, 0, EPI_FFN, 0, 0, 0, 0, BIG); n_gemm<<<dim3(FF / 64, R / 64), 256, 0, stream>>>(p, g); }
    { NG g = mk(BIG, FF, p.ffn_w_out, D, 0, EPI_RES, 0, 0, 0, 5120, nullptr); n_gemm<<<dim3(16, R / 64), 256, 0, stream>>>(p, g); }
    n_rowpass<<<1024, 256, 0, stream>>>(p, 1, 0, p.ln2_g, p.ln2_b, 1, 0);
    { NG g = mk(BUFA, D, p.cd_w_in, CIN1, 1, EPI_IN1, 1, 0, 0, 0, BIG); n_gemm<<<dim3(40, NB * SEQ / 64), 256, 0, stream>>>(p, g); }
    { NG g = mk(BUFA, D, p.cd_w_in, CIN1, 2, EPI_IN1, 1, 12, 0, 0, BIG); n_gemm<<<dim3(24, NB * CTXL / 64), 256, 0, stream>>>(p, g); }
    n_attn1<<<dim3(32, 6, NB), 256, 0, stream>>>(p);
    n_conv<<<NB * SEQ, 256, 0, stream>>>(p);
    { NG g = mk(BUFB, D, p.cd_w_out, D, 1, EPI_RES, 1, 0, 0, 2048, nullptr); n_gemm<<<dim3(16, NB * SEQ / 64), 256, 0, stream>>>(p, g); }
    n_rowpass<<<1024, 256, 0, stream>>>(p, 1, 1, p.ln1_g + D, p.ln1_b + D, 1, 3072);
    { NG g = mk(BUFA, D, p.ffn_w_in + (size_t)D * 2 * FF, 2 * FF, 1, EPI_FFN, 1, 0, 0, 0, BIG); n_gemm<<<dim3(FF / 64, NB * SEQ / 64), 256, 0, stream>>>(p, g); }
    { NG g = mk(BIG, FF, p.ffn_w_out + (size_t)FF * D, D, 1, EPI_RES, 1, 0, 0, 5120, nullptr); n_gemm<<<dim3(16, NB * SEQ / 64), 256, 0, stream>>>(p, g); }
    n_rowpass<<<1024, 256, 0, stream>>>(p, 1, 1, p.ln2_g + D, p.ln2_b + D, 0, -1);
}
```

```cpp
#include <hip/hip_runtime.h>
#include <cstdio>
#include <cstdint>
#include <cmath>
#include <cstring>
#include <hip/hip_cooperative_groups.h>
namespace cg = cooperative_groups;

constexpr int D = 1024, NB = 8, SEQ = 2048, CTXL = 256, TOK = SEQ + CTXL, R = NB * TOK;
constexpr int FF = 2816, HD = 64;
constexpr int P0 = 1536;
constexpr int P1 = 2560;
constexpr int CIN1 = 2816;
constexpr float ALPHA = 1.4142135623730951f, LN_EPS = 1e-6f;
constexpr float QSCALE = 0.125f * 1.4426950408889634f;
constexpr float LAM_INIT = 0.35550906758f;
constexpr int MODW = 6 * D;

constexpr size_t MiB = 1u << 20;
constexpr size_t WS_CTL = 0, WS_MOD = 1 * MiB, WS_ROPE = WS_MOD + 2 * 9 * MODW * 4;
constexpr size_t WS_XC = 48 * MiB, WS_BUFA = 56 * MiB, WS_BUFB = 92 * MiB, WS_BIG = 128 * MiB, WS_END = 227 * MiB;
static_assert(WS_ROPE + 2 * 64 * 16 * 4 <= 2 * MiB, "ws map");

typedef unsigned short bf16;
__device__ __forceinline__ unsigned f2bf(float f) { unsigned u = __builtin_bit_cast(unsigned, f); return (u + 0x7fffu + ((u >> 16) & 1u)) >> 16; }
__device__ __forceinline__ float bf2f(unsigned short h) { return __builtin_bit_cast(float, (unsigned)h << 16); }
__device__ __forceinline__ float silu_f(float x) { return x / (1.f + __expf(-x)); }
__device__ __forceinline__ float sigmoid_f(float x) { return 1.f / (1.f + __expf(-x)); }

struct Ptrs {
    const float *x, *c, *ctx, *c_ctx, *ab_w_in, *ab_q_gain, *ab_k_gain, *ab_w_pool, *ab_pool_scale, *ab_w_out,
        *cd_w_in, *lq1, *lk1, *lq2, *lk2, *subln, *conv_w, *conv_b, *conv_ln_g, *conv_ln_b, *cd_w_out,
        *ada_w, *ada_b, *ln1_g, *ln1_b, *ln2_g, *ln2_b, *ffn_w_in, *ffn_w_out;
    float* out; unsigned char* ws;
};
__device__ __forceinline__ float* res_row(const Ptrs& p, int r) {
    const int b = r / TOK, tp = r % TOK;
    return tp < CTXL ? (float*)(p.ws + WS_XC) + (size_t)(b * CTXL + tp) * D : p.out + (size_t)(b * SEQ + tp - CTXL) * D;
}
__device__ __forceinline__ const float* in_row(const Ptrs& p, int r) {
    const int b = r / TOK, tp = r % TOK;
    return tp < CTXL ? p.ctx + (size_t)(b * CTXL + tp) * D : p.x + (size_t)(b * SEQ + tp - CTXL) * D;
}
__device__ __forceinline__ const float* mod_vec(const Ptrs& p, int layer, int r) {
    const int b = r / TOK, tp = r % TOK;
    return (const float*)(p.ws + WS_MOD) + (size_t)(layer * 9 + (tp < CTXL ? 8 : b)) * MODW;
}

__global__ void n_prep(Ptrs p) {
    const int gid = blockIdx.x * blockDim.x + threadIdx.x;
    if (gid < 2 * 9 * MODW) {
        const int l = gid / (9 * MODW), v = (gid / MODW) % 9, j = gid % MODW;
        const float* cv = v < 8 ? p.c + v * D : p.c_ctx; const float* W = p.ada_w + (size_t)l * D * MODW;
        float acc = 0.f;
        for (int k = 0; k < D; ++k) acc += silu_f(cv[k]) * W[(size_t)k * MODW + j];
        ((float*)(p.ws + WS_MOD))[gid] = acc + p.ada_b[l * MODW + j];
    } else if (gid < 2 * 9 * MODW + 1024) {
        const int e = gid - 2 * 9 * MODW, pos = e / 16, i = e % 16;
        const double fr = pow(10000.0, -(2.0 * i) / 32.0), ang = (double)pos * fr;
        float* rope = (float*)(p.ws + WS_ROPE); rope[e] = (float)cos(ang); rope[1024 + e] = (float)sin(ang);
    }
}

__device__ __forceinline__ float wave_sum(float v) {
#pragma unroll
    for (int o = 1; o < 64; o <<= 1) v += __shfl_xor(v, o);
    return v;
}
__device__ __forceinline__ void row_pass(const Ptrs& p, int r, int lane, int mode, const float* lng, const float* lnb, int hlayer, int hoff) {
    float4 v[4];
    const float4* src = (const float4*)(mode == 0 ? in_row(p, r) : res_row(p, r));
#pragma unroll
    for (int j = 0; j < 4; ++j) v[j] = src[lane + 64 * j];
    if (mode == 1) {
        float s = 0.f;
#pragma unroll
        for (int j = 0; j < 4; ++j) s += (v[j].x + v[j].y) + (v[j].z + v[j].w);
        const float mean = wave_sum(s) * (1.f / D); float q = 0.f;
#pragma unroll
        for (int j = 0; j < 4; ++j) { v[j].x -= mean; v[j].y -= mean; v[j].z -= mean; v[j].w -= mean; q += (v[j].x * v[j].x + v[j].y * v[j].y) + (v[j].z * v[j].z + v[j].w * v[j].w); }
        const float rstd = 1.f / sqrtf(wave_sum(q) * (1.f / D) + LN_EPS);
        float4* dst = (float4*)res_row(p, r);
#pragma unroll
        for (int j = 0; j < 4; ++j) { const float4 g = ((const float4*)lng)[lane + 64 * j], b = ((const float4*)lnb)[lane + 64 * j];
            v[j].x = v[j].x * rstd * g.x + b.x; v[j].y = v[j].y * rstd * g.y + b.y; v[j].z = v[j].z * rstd * g.z + b.z; v[j].w = v[j].w * rstd * g.w + b.w; dst[lane + 64 * j] = v[j]; }
    }
    if (hoff >= 0) {
        const float* mv = mod_vec(p, hlayer, r); const float4* sh = (const float4*)(mv + hoff); const float4* sc = (const float4*)(mv + hoff + D);
        uint2* dst = (uint2*)((bf16*)(p.ws + WS_BUFA) + (size_t)r * D);
#pragma unroll
        for (int j = 0; j < 4; ++j) { const float4 a = sh[lane + 64 * j], s = sc[lane + 64 * j];
            const float h0 = v[j].x * (1.f + s.x) + a.x, h1 = v[j].y * (1.f + s.y) + a.y, h2 = v[j].z * (1.f + s.z) + a.z, h3 = v[j].w * (1.f + s.w) + a.w;
            dst[lane + 64 * j] = make_uint2(f2bf(h0) | (f2bf(h1) << 16), f2bf(h2) | (f2bf(h3) << 16)); }
    }
}
__global__ __launch_bounds__(256) void n_rowpass(Ptrs p, int mode, int latent_only, const float* lng, const float* lnb, int hlayer, int hoff) {
    const int gw = (blockIdx.x * 256 + threadIdx.x) >> 6, lane = threadIdx.x & 63, nw = (gridDim.x * 256) >> 6;
    const int nrows = latent_only ? NB * SEQ : R;
    for (int i = gw; i < nrows; i += nw) { const int r = latent_only ? (i / SEQ) * TOK + CTXL + i % SEQ : i; row_pass(p, r, lane, mode, lng, lnb, hlayer, hoff); }
}

enum { EPI_IN0 = 0, EPI_IN1 = 1, EPI_RES = 2, EPI_FFN = 3 };
struct NG { const bf16* A; const float* W; bf16* O; int K, ldw, rowmode  , epi, layer, tn0  , resid_in_is_input, gate_off; };
static NG mk(const bf16* A, int K, const float* W, int ldw, int rowmode, int epi, int layer, int tn0, int rin, int gate_off, bf16* O) {
    NG g; memset(&g, 0, sizeof(g)); g.A = A; g.W = W; g.O = O; g.K = K; g.ldw = ldw; g.rowmode = rowmode; g.epi = epi; g.layer = layer; g.tn0 = tn0; g.resid_in_is_input = rin; g.gate_off = gate_off; return g; }
__global__ __launch_bounds__(256) void n_gemm(Ptrs p, NG g) {
    __shared__ float As[16][68]; __shared__ float Ws[16][64]; __shared__ float Ws2[16][64]; __shared__ float Out[64][65]; __shared__ float Out2[64][65];
    const int tid = threadIdx.x, ty = tid >> 4, tx = tid & 15, tm = blockIdx.y, tn = blockIdx.x + g.tn0;
    int row0;
    if (g.rowmode == 0) row0 = tm * 64; else if (g.rowmode == 1) row0 = (tm / 32) * TOK + CTXL + (tm % 32) * 64; else row0 = (tm / 4) * TOK + (tm % 4) * 64;
    int c0 = tn * 64, c1 = -1;
    if (g.epi == EPI_FFN) { c1 = FF + tn * 64; }
    if (g.epi == EPI_IN1 && tn >= 36) { c0 = 2304 + (tn - 36) * 64; c1 = 2560 + (tn - 36) * 64; }
    const bool dual = c1 >= 0;
    float acc[4][4] = {}, acc2[4][4] = {};
    for (int k0 = 0; k0 < g.K; k0 += 16) {
        { const int rr = tid >> 2, kk = (tid & 3) * 4; const uint2 a = *(const uint2*)(g.A + (size_t)(row0 + rr) * g.K + k0 + kk);
          As[kk + 0][rr] = bf2f(a.x & 0xffff); As[kk + 1][rr] = bf2f(a.x >> 16); As[kk + 2][rr] = bf2f(a.y & 0xffff); As[kk + 3][rr] = bf2f(a.y >> 16); }
        { const int kk = tid >> 4, cc = (tid & 15) * 4; *(float4*)&Ws[kk][cc] = *(const float4*)(g.W + (size_t)(k0 + kk) * g.ldw + c0 + cc);
          if (dual) *(float4*)&Ws2[kk][cc] = *(const float4*)(g.W + (size_t)(k0 + kk) * g.ldw + c1 + cc); }
        __syncthreads();
#pragma unroll
        for (int kk = 0; kk < 16; ++kk) {
            float a[4], w[4], w2[4];
#pragma unroll
            for (int i = 0; i < 4; ++i) { a[i] = As[kk][ty * 4 + i]; w[i] = Ws[kk][tx * 4 + i]; w2[i] = dual ? Ws2[kk][tx * 4 + i] : 0.f; }
#pragma unroll
            for (int i = 0; i < 4; ++i)
#pragma unroll
                for (int j = 0; j < 4; ++j) { acc[i][j] += a[i] * w[j]; acc2[i][j] += a[i] * w2[j]; }
        }
        __syncthreads();
    }
#pragma unroll
    for (int i = 0; i < 4; ++i)
#pragma unroll
        for (int j = 0; j < 4; ++j) { Out[ty * 4 + i][tx * 4 + j] = acc[i][j]; Out2[ty * 4 + i][tx * 4 + j] = acc2[i][j]; }
    __syncthreads();
    const float* rope = (const float*)(p.ws + WS_ROPE);
    if (g.epi == EPI_RES) {
        for (int e = tid; e < 64 * 64; e += 256) { const int rr = e >> 6, cc = e & 63, r = row0 + rr, c = c0 + cc;
            const float xin = g.resid_in_is_input ? in_row(p, r)[c] : res_row(p, r)[c];
            res_row(p, r)[c] = ALPHA * xin + mod_vec(p, g.layer, r)[g.gate_off + c] * Out[rr][cc]; }
    } else if (g.epi == EPI_FFN) {
        for (int e = tid; e < 64 * 64; e += 256) { const int rr = e >> 6, cc = e & 63;
            g.O[(size_t)(row0 + rr) * FF + c0 + cc] = (bf16)f2bf(silu_f(Out2[rr][cc]) * Out[rr][cc]); }
    } else if (dual) {
        for (int e = tid; e < 64 * 64; e += 256) { const int rr = e >> 6, cc = e & 63;
            g.O[(size_t)(row0 + rr) * P1 + 2304 + (tn - 36) * 64 + cc] = (bf16)f2bf(Out[rr][cc] * sigmoid_f(Out2[rr][cc])); }
    } else if (tid < 64) {
        const int rr = tid, r = row0 + rr, tp = r % TOK; const bool lat = tp >= CTXL; const int t = tp - CTXL;
        int kind; const float* gain = nullptr; int pitch;
        if (g.epi == EPI_IN0) { pitch = P0; kind = tn < 12 ? 0 : (tn < 16 ? 1 : 2); gain = tn < 12 ? p.ab_q_gain : p.ab_k_gain; }
        else { pitch = P1; kind = tn < 12 ? 0 : (tn < 24 ? 1 : 2); }
        float v[64];
#pragma unroll
        for (int d = 0; d < 64; ++d) v[d] = Out[rr][d];
        if (kind < 2) {
            if (g.epi == EPI_IN0) { float ss = 0.f;
#pragma unroll
                for (int d = 0; d < 64; ++d) ss += v[d] * v[d];
                const float rs = 1.f / sqrtf(ss * (1.f / 64.f) + LN_EPS);
#pragma unroll
                for (int d = 0; d < 64; ++d) v[d] = v[d] * rs * gain[d]; }
            if (lat) {
                const int prow = t / 64, pcol = t % 64;
#pragma unroll
                for (int i = 0; i < 16; ++i) {
                    { const float c = rope[prow * 16 + i], s = rope[1024 + prow * 16 + i], x1 = v[i], x2 = v[16 + i]; v[i] = x1 * c - x2 * s; v[16 + i] = x2 * c + x1 * s; }
                    { const float c = rope[pcol * 16 + i], s = rope[1024 + pcol * 16 + i], x1 = v[32 + i], x2 = v[48 + i]; v[32 + i] = x1 * c - x2 * s; v[48 + i] = x2 * c + x1 * s; }
                }
            }
            if (kind == 0) {
#pragma unroll
                for (int d = 0; d < 64; ++d) v[d] *= QSCALE; }
        }
        bf16* o = g.O + (size_t)r * pitch + tn * 64;
#pragma unroll
        for (int d = 0; d < 64; ++d) o[d] = (bf16)f2bf(v[d]);
    }
}

__global__ __launch_bounds__(256) void n_attn0(Ptrs p) {
    const int b = blockIdx.z, h = blockIdx.y, ch = blockIdx.x, kvh = h / 3;
    const bf16* QKV = (const bf16*)(p.ws + WS_BIG);
    const int r = b * TOK + ch * 256 + threadIdx.x, nkeys = ch == 0 ? CTXL : TOK;
    float q[64], o[64];
    { const bf16* qp = QKV + (size_t)r * P0 + h * 64;
#pragma unroll
      for (int d = 0; d < 64; ++d) { q[d] = bf2f(qp[d]); o[d] = 0.f; } }
    float m = -1e30f, l = 0.f;
    for (int j = 0; j < nkeys; ++j) {
        const bf16* kp = QKV + (size_t)(b * TOK + j) * P0 + 768 + kvh * 64; const bf16* vp = kp + 256;
        float s = 0.f;
#pragma unroll
        for (int d = 0; d < 64; ++d) s += q[d] * bf2f(kp[d]);
        const float mn = fmaxf(m, s), a = exp2f(m - mn), pp = exp2f(s - mn);
        l = l * a + pp; m = mn;
#pragma unroll
        for (int d = 0; d < 64; ++d) o[d] = o[d] * a + pp * bf2f(vp[d]);
    }
    bf16* op = (bf16*)(p.ws + WS_BUFB) + (size_t)r * D + h * 64; const float il = 1.f / l;
#pragma unroll
    for (int d = 0; d < 64; ++d) op[d] = (bf16)f2bf(o[d] * il);
}
__global__ __launch_bounds__(256) void n_pool(Ptrs p) {
    __shared__ float pooled[256];
    const int r = blockIdx.x, tp = r % TOK, c = threadIdx.x, g = c >> 6; const bool lat = tp >= CTXL;
    const int t = lat ? tp - CTXL : tp, n = lat ? SEQ : CTXL, rbase = r - t;
    const bf16* U = (const bf16*)(p.ws + WS_BIG) + 1280;
    const int w = 2 << g, lo = max(t - w / 2, 0), hi = min(t + w - w / 2, n);
    float s = 0.f;
    for (int j = lo; j < hi; ++j) s += bf2f(U[(size_t)(rbase + j) * P0 + c]);
    pooled[c] = s / (float)(hi - lo) - bf2f(U[(size_t)r * P0 + c]);
    __syncthreads();
    const int d = c & 63; const float* W = p.ab_w_pool + (size_t)g * 64 * 64;
    float acc = 0.f;
    for (int cc = 0; cc < 64; ++cc) acc += pooled[g * 64 + cc] * W[cc * 64 + d];
    ((bf16*)(p.ws + WS_BUFB))[(size_t)r * D + 768 + c] = (bf16)f2bf(acc * p.ab_pool_scale[c]);
}
__global__ __launch_bounds__(256) void n_attn1(Ptrs p) {
    __shared__ float lam_s;
    const int b = blockIdx.z, h = blockIdx.y, qi = threadIdx.x >> 2, qt = threadIdx.x & 3;
    if (threadIdx.x == 0) { float a = 0.f, c = 0.f; for (int i = 0; i < 64; ++i) { a += p.lq1[i] * p.lk1[i]; c += p.lq2[i] * p.lk2[i]; } lam_s = expf(a) - expf(c) + LAM_INIT; }
    __syncthreads();
    const float lam = lam_s;
    const bf16* QKV = (const bf16*)(p.ws + WS_BIG);
    const int r = b * TOK + CTXL + blockIdx.x * 64 + qi;
    float on[2][32];
#pragma unroll
    for (int comp = 0; comp < 2; ++comp) {
        float q[64], o[32];
        { const bf16* qp = QKV + (size_t)r * P1 + (h * 2 + comp) * 64;
#pragma unroll
          for (int d = 0; d < 64; ++d) q[d] = bf2f(qp[d]);
#pragma unroll
          for (int d = 0; d < 32; ++d) o[d] = 0.f; }
        float m = -1e30f, l = 0.f;
        for (int j = 0; j < TOK; ++j) {
            const bf16* kp = QKV + (size_t)(b * TOK + j) * P1 + 768 + (h * 2 + comp) * 64; const bf16* vp = QKV + (size_t)(b * TOK + j) * P1 + 1536 + h * 128 + qt * 32;
            float s = 0.f;
#pragma unroll
            for (int d = 0; d < 64; ++d) s += q[d] * bf2f(kp[d]);
            const float mn = fmaxf(m, s), a = exp2f(m - mn), pp = exp2f(s - mn);
            l = l * a + pp; m = mn;
#pragma unroll
            for (int d = 0; d < 32; ++d) o[d] = o[d] * a + pp * bf2f(vp[d]);
        }
        const float il = 1.f / l;
#pragma unroll
        for (int d = 0; d < 32; ++d) on[comp][d] = o[d] * il;
    }
    float ss = 0.f, df[32];
#pragma unroll
    for (int d = 0; d < 32; ++d) { df[d] = on[0][d] - lam * on[1][d]; ss += df[d] * df[d]; }
    ss += __shfl_xor(ss, 1); ss += __shfl_xor(ss, 2);
    const float rs = 1.f / sqrtf(ss * (1.f / 128.f) + LN_EPS) * (1.f - LAM_INIT);
    bf16* op = (bf16*)(p.ws + WS_BUFB) + (size_t)r * D + h * 128 + qt * 32;
#pragma unroll
    for (int d = 0; d < 32; ++d) op[d] = (bf16)f2bf(df[d] * rs * p.subln[qt * 32 + d]);
}
__global__ __launch_bounds__(256) void n_conv(Ptrs p) {
    __shared__ float red[8];
    const int b = blockIdx.x / SEQ, t = blockIdx.x % SEQ, c = threadIdx.x, r = b * TOK + CTXL + t;
    const bf16* Z = (const bf16*)(p.ws + WS_BIG) + 2304;
    float acc = p.conv_b[c];
    for (int j = 0; j < 31; ++j) { const int tt = t + j - 15; if (tt >= 0 && tt < SEQ) acc += bf2f(Z[(size_t)(b * TOK + CTXL + tt) * P1 + c]) * p.conv_w[j * 256 + c]; }
    float s = wave_sum(acc); if ((c & 63) == 0) red[c >> 6] = s; __syncthreads();
    const float mean = (red[0] + red[1] + red[2] + red[3]) * (1.f / 256.f); const float dv = acc - mean;
    float q = wave_sum(dv * dv); if ((c & 63) == 0) red[4 + (c >> 6)] = q; __syncthreads();
    const float rstd = 1.f / sqrtf((red[4] + red[5] + red[6] + red[7]) * (1.f / 256.f) + LN_EPS);
    const float y = dv * rstd * p.conv_ln_g[c] + p.conv_ln_b[c];
    ((bf16*)(p.ws + WS_BUFB))[(size_t)r * D + 768 + c] = (bf16)f2bf(silu_f(y));
}

__device__ __forceinline__ int otid() { int t = threadIdx.x; asm volatile("" : "+v"(t)); return t; }
namespace pg8 {
#define PG8_LAS __attribute__((address_space(3)))
typedef unsigned short bf16_t;
typedef short bf16x8 __attribute__((ext_vector_type(8)));
typedef float f32x4 __attribute__((ext_vector_type(4)));
typedef unsigned u32x4 __attribute__((ext_vector_type(4)));
constexpr int BM = 256, BK = 64, HALF = 128, HTB = HALF * BK * 2  , STAGE_BYTES = 8 * HTB, NXCD = 8, WGM = 8;

__host__ __device__ __forceinline__ int lds_byte(int r, int c) { const int st = (r >> 4) * 2 + (c >> 5), rr = r & 15, cc = c & 31, ob = rr * 64 + cc * 2; return st * 1024 + (ob ^ (((ob >> 9) & 1) << 5)); }
__host__ __device__ __forceinline__ void stage_rc(int b, int& R, int& C) { const int st = b / 1024, sb = b % 1024, swz = sb ^ (((sb >> 9) & 1) << 5); R = (st >> 1) * 16 + swz / 64; C = (st & 1) * 32 + (swz % 64) / 2; }
__host__ __device__ __forceinline__ int perm32(int rho) { const int n = rho >> 4, i = rho & 15; return 8 * (i >> 2) + 4 * n + (i & 3); }

struct Unit { int pm, pn; };
struct Gemm { const bf16_t* A; const bf16_t* Bt; int M, N, K; };

__device__ __forceinline__ unsigned cvt_pk_bf16(float lo, float hi) { unsigned r; asm volatile("v_cvt_pk_bf16_f32 %0, %1, %2" : "=v"(r) : "v"(lo), "v"(hi)); return r; }
typedef float f32x2 __attribute__((ext_vector_type(2)));

template <class Epi, class Sched, bool ALIGN_EPI = false, bool SP2 = false>
__device__ __forceinline__ void gemm_phase(PG8_LAS unsigned char* lds, const Gemm g, const Sched& S, const Epi& E) {
    const int tid = otid(), wid = __builtin_amdgcn_readfirstlane(tid >> 6), lane = tid & 63, wr = wid >> 2, wc = wid & 3, fr = lane & 15, fq = lane >> 4;
    const int K = g.K, nt = K / BK;
    unsigned voffA[2], voffB[2];
#pragma unroll
    for (int i = 0; i < 2; ++i) { int R, C; stage_rc(tid * 16 + i * 8192, R, C); const int Rb = Epi::PERM ? ((R & ~31) + perm32(R & 31)) : R;
        voffA[i] = (unsigned)(R * K + C) * 2u; voffB[i] = (unsigned)(Rb * K + C) * 2u; }
    const size_t kstep = (size_t)(BK * 2);
    const size_t hstep = (size_t)HALF * K * 2;
    const size_t tstep = 2 * hstep;
    const unsigned ldsw = (unsigned)wid * 1024u;
    const int aoff = lds_byte(wr * 64 + fr, fq * 8), boff = lds_byte(wc * 32 + fr, fq * 8);
#define PG8_SA(b, h) (((b) * 2 + (h)) * HTB)
#define PG8_SB(b, h) ((4 + (b) * 2 + (h)) * HTB)
#define PG8_STAGE(bufoff, gbase, voff) do { _Pragma("unroll") for (int _i = 0; _i < 2; ++_i) \
        __builtin_amdgcn_global_load_lds((const unsigned*)((const char*)(gbase) + (voff)[_i]), (PG8_LAS unsigned*)(lds + (bufoff) + ldsw + _i * 8192), 16, 0, 0); } while (0)
#define PG8_LDA(dst, b, h) do { _Pragma("unroll") for (int m = 0; m < 4; ++m) _Pragma("unroll") for (int k = 0; k < 2; ++k) dst[m][k] = *(const PG8_LAS bf16x8*)(lds + PG8_SA(b, h) + aoff + m * 2048 + k * 1024); } while (0)
#define PG8_LDB(dst, b, h) do { _Pragma("unroll") for (int n = 0; n < 2; ++n) _Pragma("unroll") for (int k = 0; k < 2; ++k) dst[n][k] = *(const PG8_LAS bf16x8*)(lds + PG8_SB(b, h) + boff + n * 2048 + k * 1024); } while (0)
#define PG8_MMA(ai, bj, At, Bt) do { __builtin_amdgcn_s_setprio(1); _Pragma("unroll") for (int m = 0; m < 4; ++m) _Pragma("unroll") for (int n = 0; n < 2; ++n) _Pragma("unroll") for (int k = 0; k < 2; ++k) \
        acc[ai][bj][m][n] = __builtin_amdgcn_mfma_f32_16x16x32_bf16(Bt[n][k], At[m][k], acc[ai][bj][m][n], 0, 0, 0); __builtin_amdgcn_s_setprio(0); } while (0)
#define PG8_WAIT_V(n) asm volatile("s_waitcnt vmcnt(" #n ")" ::: "memory")
#define PG8_WAIT_L(n) asm volatile("s_waitcnt lgkmcnt(" #n ")" ::: "memory")
#define PG8_BAR __builtin_amdgcn_s_barrier()
#define PG8_SCHED __builtin_amdgcn_sched_barrier(0)
    Unit cur, nxt; int ui = 0;
    if (!S.next(0, cur)) return;
    f32x4 acc[2][2][4][2];
#pragma unroll
    for (int a = 0; a < 2; ++a)
#pragma unroll
        for (int b = 0; b < 2; ++b)
#pragma unroll
            for (int m = 0; m < 4; ++m)
#pragma unroll
                for (int n = 0; n < 2; ++n) acc[a][b][m][n] = (f32x4){0.f, 0.f, 0.f, 0.f};
    bf16x8 At[4][2], B0[2][2], B1[2][2];
    const char* cA = (const char*)g.A + (size_t)cur.pm * tstep; const char* cB = (const char*)g.Bt + (size_t)cur.pn * tstep;
    S.a_ready(cur);
    if constexpr (SP2) {
        PG8_STAGE(PG8_SB(0, 0), cB, voffB); PG8_STAGE(PG8_SB(0, 1), cB + hstep, voffB); PG8_STAGE(PG8_SA(0, 0), cA, voffA); PG8_STAGE(PG8_SA(0, 1), cA + hstep, voffA);
        if (wr == 1) PG8_BAR;
        PG8_WAIT_V(2); PG8_BAR;
        PG8_STAGE(PG8_SB(1, 0), cB + kstep, voffB); PG8_STAGE(PG8_SA(1, 0), cA + kstep, voffA); PG8_STAGE(PG8_SB(1, 1), cB + hstep + kstep, voffB);
        PG8_WAIT_V(6); PG8_BAR;
    } else {
        PG8_STAGE(PG8_SB(0, 0), cB, voffB); PG8_STAGE(PG8_SA(0, 0), cA, voffA); PG8_STAGE(PG8_SB(0, 1), cB + hstep, voffB); PG8_STAGE(PG8_SA(0, 1), cA + hstep, voffA);
        if (wr == 1) PG8_BAR;
        PG8_WAIT_V(4); PG8_BAR;
        PG8_STAGE(PG8_SB(1, 0), cB + kstep, voffB); PG8_STAGE(PG8_SA(1, 0), cA + kstep, voffA); PG8_STAGE(PG8_SB(1, 1), cB + hstep + kstep, voffB);
        PG8_WAIT_V(6); PG8_BAR;
    }
    for (;;) {
        const bool has_next = S.next(ui + 1, nxt);
        const char* nA = has_next ? (const char*)g.A + (size_t)nxt.pm * tstep : cA; const char* nB = has_next ? (const char*)g.Bt + (size_t)nxt.pn * tstep : cB;
        for (int t = 0; t < nt; t += 2) {
            const bool last = (t == nt - 2);
            const char* a1 = cA + (size_t)(t + 1) * kstep;
            const char* a2 = last ? nA : cA + (size_t)(t + 2) * kstep; const char* b2 = last ? nB : cB + (size_t)(t + 2) * kstep;
            const char* a3 = a2 + kstep; const char* b3 = b2 + kstep;
            if (last && has_next) S.a_ready(nxt);
            if constexpr (SP2) {
            PG8_LDB(B0, 0, 0); PG8_LDB(B1, 0, 1); PG8_SCHED; PG8_LDA(At, 0, 0); PG8_STAGE(PG8_SA(1, 1), a1 + hstep, voffA);
            PG8_WAIT_V(8); PG8_WAIT_L(0); PG8_BAR; PG8_MMA(0, 0, At, B0); PG8_MMA(0, 1, At, B1); PG8_BAR; PG8_SCHED;
            PG8_LDA(At, 0, 1); PG8_STAGE(PG8_SB(0, 0), b2, voffB); PG8_STAGE(PG8_SB(0, 1), b2 + hstep, voffB); PG8_STAGE(PG8_SA(0, 0), a2, voffA);
            PG8_WAIT_V(8); PG8_WAIT_L(0); PG8_BAR; PG8_MMA(1, 0, At, B0); PG8_MMA(1, 1, At, B1); PG8_BAR; PG8_SCHED;
            PG8_LDB(B0, 1, 0); PG8_LDB(B1, 1, 1); PG8_SCHED; PG8_LDA(At, 1, 0); PG8_STAGE(PG8_SA(0, 1), a2 + hstep, voffA);
            PG8_WAIT_V(8); PG8_WAIT_L(0); PG8_BAR; PG8_MMA(0, 0, At, B0); PG8_MMA(0, 1, At, B1); PG8_BAR; PG8_SCHED;
            PG8_LDA(At, 1, 1); PG8_STAGE(PG8_SB(1, 0), b3, voffB); PG8_STAGE(PG8_SB(1, 1), b3 + hstep, voffB); PG8_STAGE(PG8_SA(1, 0), a3, voffA);
            PG8_WAIT_V(8); PG8_WAIT_L(0); PG8_BAR; PG8_MMA(1, 0, At, B0); PG8_MMA(1, 1, At, B1); PG8_BAR; PG8_SCHED;
            } else {
            PG8_LDB(B0, 0, 0); PG8_SCHED; PG8_LDA(At, 0, 0); PG8_STAGE(PG8_SA(1, 1), a1 + hstep, voffA);
            PG8_WAIT_L(8); PG8_BAR; PG8_WAIT_L(0); PG8_MMA(0, 0, At, B0); PG8_BAR; PG8_SCHED;
            PG8_LDB(B1, 0, 1); PG8_STAGE(PG8_SB(0, 0), b2, voffB);
            PG8_BAR; PG8_WAIT_L(0); PG8_MMA(0, 1, At, B1); PG8_BAR;
            PG8_LDA(At, 0, 1); PG8_STAGE(PG8_SA(0, 0), a2, voffA);
            PG8_BAR; PG8_WAIT_L(0); PG8_MMA(1, 0, At, B0); PG8_BAR; PG8_SCHED;
            PG8_STAGE(PG8_SB(0, 1), b2 + hstep, voffB);
            PG8_WAIT_V(6); PG8_BAR; PG8_MMA(1, 1, At, B1); PG8_BAR;
            PG8_LDB(B0, 1, 0); PG8_SCHED; PG8_LDA(At, 1, 0); PG8_STAGE(PG8_SA(0, 1), a2 + hstep, voffA);
            PG8_WAIT_L(8); PG8_BAR; PG8_WAIT_L(0); PG8_MMA(0, 0, At, B0); PG8_BAR; PG8_SCHED;
            PG8_LDB(B1, 1, 1); PG8_STAGE(PG8_SB(1, 0), b3, voffB);
            PG8_BAR; PG8_WAIT_L(0); PG8_MMA(0, 1, At, B1); PG8_BAR;
            PG8_LDA(At, 1, 1); PG8_STAGE(PG8_SA(1, 0), a3, voffA);
            PG8_BAR; PG8_WAIT_L(0); PG8_MMA(1, 0, At, B0); PG8_BAR; PG8_SCHED;
            PG8_STAGE(PG8_SB(1, 1), b3 + hstep, voffB);
            PG8_WAIT_V(6); PG8_BAR; PG8_MMA(1, 1, At, B1); PG8_BAR;
            }
        }
        if constexpr (ALIGN_EPI) { if (wr == 0) PG8_BAR; }
        if constexpr (!Epi::AFTER_DRAIN) { E(acc, cur, wr, wc, fr, fq); S.done(cur); }
        if (!has_next) break;
#pragma unroll
        for (int a = 0; a < 2; ++a)
#pragma unroll
            for (int b = 0; b < 2; ++b)
#pragma unroll
                for (int m = 0; m < 4; ++m)
#pragma unroll
                    for (int n = 0; n < 2; ++n) acc[a][b][m][n] = (f32x4){0.f, 0.f, 0.f, 0.f};
        cur = nxt; cA = nA; cB = nB; ++ui;
        if constexpr (ALIGN_EPI) { if (wr == 1) PG8_BAR; }
    }
    PG8_WAIT_V(0);
    if constexpr (!ALIGN_EPI) { if (wr == 0) PG8_BAR; }
    PG8_BAR;
    if constexpr (Epi::AFTER_DRAIN) { E.fused(acc, cur, wr, wc, fr, fq, lds, wid, lane); S.done(cur); }
#undef PG8_SA
#undef PG8_SB
#undef PG8_STAGE
#undef PG8_LDA
#undef PG8_LDB
#undef PG8_MMA
#undef PG8_WAIT_V
#undef PG8_WAIT_L
#undef PG8_BAR
#undef PG8_SCHED
}
}

#define LAS __attribute__((address_space(3)))
typedef float f32x4 __attribute__((ext_vector_type(4)));
typedef unsigned u32x4 __attribute__((ext_vector_type(4)));
typedef unsigned u32x2 __attribute__((ext_vector_type(2)));
typedef float f32x2 __attribute__((ext_vector_type(2)));
constexpr int NWAVES = 8, NTHR = 512;
constexpr size_t WS_WIN0 = 2 * MiB, WS_WOUT0 = 5 * MiB, WS_WIN1 = 7 * MiB, WS_WOUT1 = 12 * MiB + 512 * 1024, WS_WFIN = 14 * MiB + 512 * 1024, WS_WFOUT = 36 * MiB + 512 * 1024;
static_assert(WS_WFOUT + 2 * (size_t)D * FF * 2 <= WS_XC, "weights fit below XC");
constexpr int LDS_BYTES = 147456;

__device__ __forceinline__ float fast_rcp(float x) { return __builtin_amdgcn_rcpf(x); }
__device__ __forceinline__ float silu_fast(float x) { return x * fast_rcp(1.f + __builtin_amdgcn_exp2f(-1.4426950408889634f * x)); }
__device__ __forceinline__ float sigmoid_fast(float x) { return fast_rcp(1.f + __builtin_amdgcn_exp2f(-1.4426950408889634f * x)); }

__device__ __forceinline__ int srccol(int kind, int n0) {
    const int t = n0 >> 8, p = n0 & 255;
    if (kind == 0) return n0;
    if (kind == 1 || (kind == 2 && n0 < 2304)) return t * 256 + 64 * ((p >> 5) & 3) + 32 * (p >> 7);
    if (kind == 2) return 2304 + (p >> 7) * 256 + 128 * (t - 9) + (p & 127);
    return (p >> 7) * FF + 128 * t + (p & 127);
}
__device__ __forceinline__ unsigned pk2(float lo, float hi) { return f2bf(lo) | (f2bf(hi) << 16); }
__device__ __forceinline__ void transpose_item(const float* W, int K, int N, bf16* WT, int kind, LAS float* scr, int item, int lane) {
    const int nblk = N / 32, kb = item / nblk, nb = item % nblk, k0 = 64 * kb, n0 = 32 * nb, s0 = srccol(kind, n0);
#pragma unroll 8
    for (int i = 0; i < 32; ++i) { const int kk = 2 * i + (lane >> 5); scr[kk * 33 + (lane & 31)] = W[(size_t)(k0 + kk) * N + s0 + (lane & 31)]; }
    asm volatile("s_waitcnt lgkmcnt(0)" ::: "memory");
    const int c = lane & 7;
#pragma unroll
    for (int j = 0; j < 4; ++j) { const int n = (lane >> 3) + 8 * j; const LAS float* s = scr + (8 * c) * 33 + n;
        u32x4 o; o.x = pk2(s[0 * 33], s[1 * 33]); o.y = pk2(s[2 * 33], s[3 * 33]); o.z = pk2(s[4 * 33], s[5 * 33]); o.w = pk2(s[6 * 33], s[7 * 33]);
        *(u32x4*)(WT + (size_t)(n0 + n) * K + k0 + 8 * c) = o; }
    asm volatile("s_waitcnt lgkmcnt(0)" ::: "memory");
}
__device__ __forceinline__ void phase_prep(const Ptrs& p, LAS unsigned char* lds, int vcu, int G, int tid, int wave, int lane) {
    {
        LAS float* scr = (LAS float*)(lds + wave * 16384);
        const int gw = vcu * NWAVES + wave, NGW = G * NWAVES;
        constexpr int I0 = 16 * (P0 / 32), I1 = 16 * (D / 32), I2 = 16 * (CIN1 / 32), I3 = I1, I4 = 16 * (2 * FF / 32), I5 = (FF / 64) * (D / 32);
        constexpr int NITEMS = I0 + I1 + I2 + I3 + 2 * I4 + 2 * I5;
        for (int it = gw; it < NITEMS; it += NGW) {
            int r = it;
            if (r < I0) { transpose_item(p.ab_w_in, D, P0, (bf16*)(p.ws + WS_WIN0), 1, scr, r, lane); continue; } r -= I0;
            if (r < I1) { transpose_item(p.ab_w_out, D, D, (bf16*)(p.ws + WS_WOUT0), 0, scr, r, lane); continue; } r -= I1;
            if (r < I2) { transpose_item(p.cd_w_in, D, CIN1, (bf16*)(p.ws + WS_WIN1), 2, scr, r, lane); continue; } r -= I2;
            if (r < I3) { transpose_item(p.cd_w_out, D, D, (bf16*)(p.ws + WS_WOUT1), 0, scr, r, lane); continue; } r -= I3;
            if (r < 2 * I4) { const int l = r / I4; transpose_item(p.ffn_w_in + (size_t)l * D * 2 * FF, D, 2 * FF, (bf16*)(p.ws + WS_WFIN) + (size_t)l * 2 * FF * D, 3, scr, r % I4, lane); continue; } r -= 2 * I4;
            { const int l = r / I5; transpose_item(p.ffn_w_out + (size_t)l * FF * D, FF, D, (bf16*)(p.ws + WS_WFOUT) + (size_t)l * D * FF, 0, scr, r % I5, lane); }
        }
    }
    __syncthreads();
    if (vcu < 48) {
        LAS float* sl = (LAS float*)lds;
        LAS float* part = (LAS float*)(lds + 9 * 1024 * 4);
        for (int e = tid; e < 9 * 1024; e += NTHR) { const int v = e >> 10, k = e & 1023; sl[e] = silu_f(v < 8 ? p.c[v * D + k] : p.c_ctx[k]); }
        __syncthreads();
        const int l = vcu / 24, cb = (vcu % 24) * 256;
        const float* W = p.ada_w + (size_t)l * D * MODW + cb + 4 * lane;
        f32x4 acc[9];
#pragma unroll
        for (int v = 0; v < 9; ++v) acc[v] = (f32x4){0.f, 0.f, 0.f, 0.f};
#pragma unroll 4
        for (int kk = 0; kk < 128; ++kk) { const int k = wave * 128 + kk; const f32x4 w = *(const f32x4*)(W + (size_t)k * MODW);
#pragma unroll
            for (int v = 0; v < 9; ++v) acc[v] += w * sl[v * 1024 + k]; }
#pragma unroll
        for (int v = 0; v < 9; ++v) *(LAS f32x4*)(part + (wave * 9 + v) * 256 + 4 * lane) = acc[v];
        __syncthreads();
        for (int e = tid; e < 9 * 256; e += NTHR) { const int v = e >> 8, c = e & 255; float s = 0.f;
#pragma unroll
            for (int w = 0; w < 8; ++w) s += part[(w * 9 + v) * 256 + c];
            ((float*)(p.ws + WS_MOD))[(size_t)(l * 9 + v) * MODW + cb + c] = s + p.ada_b[l * MODW + cb + c]; }
        __syncthreads();
    } else if (vcu == 48) {
        for (int e = tid; e < 1024; e += NTHR) { const int pos = e / 16, i = e % 16; const double fr = pow(10000.0, -(2.0 * i) / 32.0), ang = (double)pos * fr;
            float* rope = (float*)(p.ws + WS_ROPE); rope[e] = (float)cos(ang); rope[1024 + e] = (float)sin(ang); }
    }
}

struct TileSched {
    int nM, nN, nwg, G, c, mode, extra;
    __device__ __forceinline__ void init(int nM_, int nN_, int G_, int c_, int mode_, int extra_) { nM = nM_; nN = nN_; nwg = nM * nN; G = G_; c = c_; mode = mode_; extra = extra_; }
    __device__ __forceinline__ bool next(int i, pg8::Unit& u) const {
        const long L = (long)i * G + c; if (L >= nwg + extra) return false;
        if (L >= nwg) { const int e = (int)L - nwg; u.pm = (e / 6) * 9; u.pn = 3 + e % 6; return true; }
        int wgid = (int)L; { const int q = nwg / 8, r = nwg % 8, xcd = wgid % 8, off = wgid / 8; wgid = (xcd < r ? xcd * (q + 1) : r * (q + 1) + (xcd - r) * q) + off; }
        const int nig = 8 * nN, gid = wgid / nig, fm = gid * 8, gsz = (nM - fm) < 8 ? (nM - fm) : 8;
        const int lp = fm + ((wgid % nig) % gsz); u.pn = (wgid % nig) / gsz;
        u.pm = mode ? (lp >> 3) * 9 + 1 + (lp & 7) : lp; return true;
    }
    __device__ __forceinline__ void a_ready(const pg8::Unit&) const {}
    __device__ __forceinline__ void done(const pg8::Unit&) const {}
};
struct EpiIn {
    static constexpr bool PERM = false, AFTER_DRAIN = false;
    const Ptrs* p; int layer;
    __device__ __forceinline__ void operator()(const f32x4 (&acc)[2][2][4][2], const pg8::Unit& u, int wr, int wc, int fr, int fq) const {
        const int pn = u.pn, kind = layer == 0 ? (pn < 3 ? 0 : (pn == 3 ? 1 : 2)) : (pn < 3 ? 0 : (pn < 6 ? 1 : (pn < 9 ? 2 : 3)));
        const int pitch = layer == 0 ? P0 : P1, jrow = u.pm % 9; const bool lat = jrow != 0;
        bf16* O = (bf16*)(p->ws + WS_BIG);
        const float* rope = (const float*)(p->ws + WS_ROPE);
        int lrow = wr * 64 + fr; asm volatile("" : "+v"(lrow));
        f32x4 gn[2][2];
#pragma unroll
        for (int bj = 0; bj < 2; ++bj)
#pragma unroll
            for (int n = 0; n < 2; ++n) gn[bj][n] = (layer == 0 && kind < 2) ? *(const f32x4*)((kind == 0 ? p->ab_q_gain : p->ab_k_gain) + bj * 32 + n * 16 + 4 * fq) : (f32x4){1.f, 1.f, 1.f, 1.f};
#pragma unroll
        for (int ai = 0; ai < 2; ++ai)
#pragma unroll
            for (int m = 0; m < 4; ++m) {
                const int rr = ai * 128 + m * 16 + lrow; const size_t r = (size_t)u.pm * 256 + rr;
                f32x4 a[2][2];
#pragma unroll
                for (int bj = 0; bj < 2; ++bj)
#pragma unroll
                    for (int n = 0; n < 2; ++n) a[bj][n] = acc[ai][bj][m][n];
                if (kind < 2) {
                    if (layer == 0) {
                        float ss = 0.f;
#pragma unroll
                        for (int bj = 0; bj < 2; ++bj)
#pragma unroll
                            for (int n = 0; n < 2; ++n) { const f32x4 x = a[bj][n]; ss += (x[0] * x[0] + x[1] * x[1]) + (x[2] * x[2] + x[3] * x[3]); }
                        ss += __shfl_xor(ss, 16); ss += __shfl_xor(ss, 32);
                        const float rs = 1.f / sqrtf(ss * (1.f / 64.f) + LN_EPS);
#pragma unroll
                        for (int bj = 0; bj < 2; ++bj)
#pragma unroll
                            for (int n = 0; n < 2; ++n) a[bj][n] = a[bj][n] * rs * gn[bj][n];
                    }
                    if (lat) {
                        const int t = (jrow - 1) * 256 + rr, prow = t >> 6, pcol = t & 63;
#pragma unroll
                        for (int bj = 0; bj < 2; ++bj) { const int pos = bj ? pcol : prow;
                            const f32x4 c4 = *(const f32x4*)(rope + pos * 16 + 4 * fq), s4 = *(const f32x4*)(rope + 1024 + pos * 16 + 4 * fq);
                            const f32x4 x1 = a[bj][0], x2 = a[bj][1]; a[bj][0] = x1 * c4 - x2 * s4; a[bj][1] = x2 * c4 + x1 * s4; }
                    }
                    if (kind == 0) {
#pragma unroll
                        for (int bj = 0; bj < 2; ++bj)
#pragma unroll
                            for (int n = 0; n < 2; ++n) a[bj][n] = a[bj][n] * QSCALE; }
                }
                if (kind < 3) {
                    bf16* o = O + r * pitch + pn * 256 + wc * 64 + 4 * fq;
#pragma unroll
                    for (int bj = 0; bj < 2; ++bj)
#pragma unroll
                        for (int n = 0; n < 2; ++n) { const f32x4 x = a[bj][n]; u32x2 w; w.x = pg8::cvt_pk_bf16(x[0], x[1]); w.y = pg8::cvt_pk_bf16(x[2], x[3]); *(u32x2*)(o + bj * 32 + n * 16) = w; }
                } else {
                    bf16* o = O + r * P1 + 2304 + (pn - 9) * 128 + wc * 32 + 4 * fq;
#pragma unroll
                    for (int n = 0; n < 2; ++n) { const f32x4 x = a[0][n], g = a[1][n]; u32x2 w;
                        w.x = pg8::cvt_pk_bf16(x[0] * sigmoid_fast(g[0]), x[1] * sigmoid_fast(g[1])); w.y = pg8::cvt_pk_bf16(x[2] * sigmoid_fast(g[2]), x[3] * sigmoid_fast(g[3])); *(u32x2*)(o + n * 16) = w; }
                }
            }
    }
};
struct EpiRes {
    static constexpr bool PERM = false, AFTER_DRAIN = false;
    const Ptrs* p; int layer, gate_off, in_is_input;
    __device__ __forceinline__ void operator()(const f32x4 (&acc)[2][2][4][2], const pg8::Unit& u, int wr, int wc, int fr, int fq) const {
        const int b = u.pm / 9, j = u.pm % 9; const bool isctx = j == 0;
        const float* gate = (const float*)(p->ws + WS_MOD) + (size_t)(layer * 9 + (isctx ? 8 : b)) * MODW + gate_off;
        float* resbase = isctx ? (float*)(p->ws + WS_XC) + (size_t)(b * CTXL) * D : p->out + (size_t)(b * SEQ + (j - 1) * 256) * D;
        const float* inbase = in_is_input ? (isctx ? p->ctx + (size_t)(b * CTXL) * D : p->x + (size_t)(b * SEQ + (j - 1) * 256) * D) : resbase;
        const int col0 = u.pn * 256 + wc * 32 + 4 * fq;
        int lrow = wr * 64 + fr; asm volatile("" : "+v"(lrow));
        f32x4 gv[2][2];
#pragma unroll
        for (int bj = 0; bj < 2; ++bj)
#pragma unroll
            for (int n = 0; n < 2; ++n) gv[bj][n] = *(const f32x4*)(gate + col0 + bj * 128 + n * 16);
#pragma unroll
        for (int ai = 0; ai < 2; ++ai)
#pragma unroll
            for (int m = 0; m < 4; ++m) { const size_t off = (size_t)(ai * 128 + m * 16 + lrow) * D + col0;
#pragma unroll
                for (int bj = 0; bj < 2; ++bj)
#pragma unroll
                    for (int n = 0; n < 2; ++n) { const f32x4 xin = *(const f32x4*)(inbase + off + bj * 128 + n * 16);
                        *(f32x4*)(resbase + off + bj * 128 + n * 16) = xin * ALPHA + gv[bj][n] * acc[ai][bj][m][n]; } }
    }
};
struct EpiFfn {
    static constexpr bool PERM = true, AFTER_DRAIN = false;
    bf16* O;
    __device__ __forceinline__ void operator()(const f32x4 (&acc)[2][2][4][2], const pg8::Unit& u, int wr, int wc, int fr, int fq) const {
        const int h0 = u.pn * 128 + wc * 32 + 8 * fq;
        int lrow = wr * 64 + fr; asm volatile("" : "+v"(lrow));
#pragma unroll
        for (int ai = 0; ai < 2; ++ai)
#pragma unroll
            for (int m = 0; m < 4; ++m) { const size_t r = (size_t)u.pm * 256 + ai * 128 + m * 16 + lrow;
                const f32x4 a0 = acc[ai][0][m][0], a1 = acc[ai][0][m][1], g0 = acc[ai][1][m][0], g1 = acc[ai][1][m][1]; u32x4 w;
                w.x = pg8::cvt_pk_bf16(silu_fast(g0[0]) * a0[0], silu_fast(g0[1]) * a0[1]); w.y = pg8::cvt_pk_bf16(silu_fast(g0[2]) * a0[2], silu_fast(g0[3]) * a0[3]);
                w.z = pg8::cvt_pk_bf16(silu_fast(g1[0]) * a1[0], silu_fast(g1[1]) * a1[1]); w.w = pg8::cvt_pk_bf16(silu_fast(g1[2]) * a1[2], silu_fast(g1[3]) * a1[3]);
                *(u32x4*)(O + r * FF + h0) = w; }
    }
};
namespace att {
typedef short bf16x8 __attribute__((ext_vector_type(8)));
typedef short s16x4 __attribute__((ext_vector_type(4)));
typedef float f32x16 __attribute__((ext_vector_type(16)));
#define SBAR() __builtin_amdgcn_sched_barrier(0)
constexpr float THR = 8.f;
__device__ __forceinline__ int crow(int r, int hi) { return (r & 3) + 8 * (r >> 2) + 4 * hi; }
__device__ __forceinline__ unsigned cvtpk(float lo, float hi) { unsigned r; asm volatile("v_cvt_pk_bf16_f32 %0, %1, %2" : "=v"(r) : "v"(lo), "v"(hi)); return r; }
__device__ __forceinline__ void partialSM(f32x16& p0, f32x16& p1, float& m_reg, float& mn, float& alpha) {
    float pmax = p0[0];
#pragma unroll
    for (int r = 1; r < 16; ++r) pmax = fmaxf(pmax, p0[r]);
#pragma unroll
    for (int r = 0; r < 16; ++r) pmax = fmaxf(pmax, p1[r]);
    { auto rr = __builtin_amdgcn_permlane32_swap(__float_as_uint(pmax), __float_as_uint(pmax), false, false); pmax = fmaxf(__uint_as_float(rr[0]), __uint_as_float(rr[1])); }
    if (__builtin_expect(__all(pmax - m_reg <= THR), 1)) { mn = m_reg; alpha = 1.f; }
    else { mn = fmaxf(m_reg, pmax); alpha = __builtin_amdgcn_exp2f(m_reg - mn); m_reg = mn; }
#pragma unroll
    for (int r = 0; r < 16; ++r) { p0[r] -= mn; p1[r] -= mn; }
#pragma unroll
    for (int r = 0; r < 16; ++r) p0[r] = __builtin_amdgcn_exp2f(p0[r]);
}
__device__ __forceinline__ void finishSM(f32x16& p0, f32x16& p1, float alpha, float& l_reg, bf16x8& pa0, bf16x8& pa1, bf16x8& pa2, bf16x8& pa3) {
#pragma unroll
    for (int r = 0; r < 16; ++r) p1[r] = __builtin_amdgcn_exp2f(p1[r]);
    float ps = 0;
#pragma unroll
    for (int r = 0; r < 16; ++r) ps += p0[r];
#pragma unroll
    for (int r = 0; r < 16; ++r) ps += p1[r];
    { auto rr = __builtin_amdgcn_permlane32_swap(__float_as_uint(ps), __float_as_uint(ps), false, false); ps = __uint_as_float(rr[0]) + __uint_as_float(rr[1]); }
    l_reg = l_reg * alpha + ps;
#define PK4(P, BASE, OUT) do { unsigned a0 = cvtpk(P[BASE + 0], P[BASE + 1]), a1 = cvtpk(P[BASE + 2], P[BASE + 3]);   \
    unsigned b0 = cvtpk(P[BASE + 4], P[BASE + 5]), b1 = cvtpk(P[BASE + 6], P[BASE + 7]);                              \
    auto r0 = __builtin_amdgcn_permlane32_swap(a0, b0, false, false); auto r1 = __builtin_amdgcn_permlane32_swap(a1, b1, false, false); \
    u32x4 w = {r0[0], r1[0], r0[1], r1[1]}; OUT = __builtin_bit_cast(bf16x8, w); } while (0)
    PK4(p0, 0, pa0); PK4(p0, 8, pa1); PK4(p1, 0, pa2); PK4(p1, 8, pa3);
#undef PK4
}
__device__ __forceinline__ int kswz(int row, int colB) { return row * 128 + (colB ^ (((row >> 1) & 7) << 4)); }
__device__ __forceinline__ void qkt(f32x16& p0, f32x16& p1, LAS const unsigned char* Ks, const bf16x8 (&qr)[4], int r32, int hi) {
    p0 = f32x16{}; p1 = f32x16{};
#pragma unroll
    for (int d0 = 0; d0 < 4; ++d0) { const int cb = d0 * 32 + hi * 16;
        const bf16x8 b0 = *(LAS const bf16x8*)(Ks + kswz(r32, cb));
        const bf16x8 b1 = *(LAS const bf16x8*)(Ks + kswz(32 + r32, cb));
        p0 = __builtin_amdgcn_mfma_f32_32x32x16_bf16(b0, qr[d0], p0, 0, 0, 0);
        p1 = __builtin_amdgcn_mfma_f32_32x32x16_bf16(b1, qr[d0], p1, 0, 0, 0); }
}
template <int DV> __device__ __forceinline__ int v_st(int k, int c) { const int kk = (k & ~0xC) | ((k & 4) << 1) | ((k & 8) >> 1); return ((kk >> 3) * (DV / 32) + (c >> 5)) * 512 + ((kk & 7) * 32 + (c & 31)) * 2; }
__device__ __forceinline__ int v_rd_base(int lane) { return ((lane & 3) << 3) | (((lane >> 2) & 3) << 6) | (((lane >> 4) & 1) << 5) | (((lane >> 5) & 1) << 8); }
template <int DV> constexpr int v_rd_off(int d0, int ks, int half) { return d0 * 512 + ks * (2 * (DV / 32) * 512) + half * ((DV / 32) * 512); }
template <int OFF> __device__ __forceinline__ s16x4 tr_read(int vb) { s16x4 r; asm volatile("ds_read_b64_tr_b16 %0, %1 offset:%2" : "=&v"(r) : "v"(vb), "i"(OFF) : "memory"); return r; }
template <int DV, int D0> __device__ __forceinline__ void pv_one(f32x16& od, int vb, bf16x8 pa0, bf16x8 pa1, bf16x8 pa2, bf16x8 pa3) {
    const s16x4 l0 = tr_read<v_rd_off<DV>(D0, 0, 0)>(vb), h0 = tr_read<v_rd_off<DV>(D0, 0, 1)>(vb), l1 = tr_read<v_rd_off<DV>(D0, 1, 0)>(vb), h1 = tr_read<v_rd_off<DV>(D0, 1, 1)>(vb);
    const s16x4 l2 = tr_read<v_rd_off<DV>(D0, 2, 0)>(vb), h2 = tr_read<v_rd_off<DV>(D0, 2, 1)>(vb), l3 = tr_read<v_rd_off<DV>(D0, 3, 0)>(vb), h3 = tr_read<v_rd_off<DV>(D0, 3, 1)>(vb);
    asm volatile("s_waitcnt lgkmcnt(0)" ::: "memory"); SBAR();
#define PK(L, H) (bf16x8){L[0], L[1], L[2], L[3], H[0], H[1], H[2], H[3]}
    od = __builtin_amdgcn_mfma_f32_32x32x16_bf16(pa0, PK(l0, h0), od, 0, 0, 0);
    od = __builtin_amdgcn_mfma_f32_32x32x16_bf16(pa1, PK(l1, h1), od, 0, 0, 0);
    od = __builtin_amdgcn_mfma_f32_32x32x16_bf16(pa2, PK(l2, h2), od, 0, 0, 0);
    od = __builtin_amdgcn_mfma_f32_32x32x16_bf16(pa3, PK(l3, h3), od, 0, 0, 0);
#undef PK
}
template <int DV> __device__ __forceinline__ void pv_all(f32x16 (&o)[DV / 32], int vb, bf16x8 pa0, bf16x8 pa1, bf16x8 pa2, bf16x8 pa3) {
    pv_one<DV, 0>(o[0], vb, pa0, pa1, pa2, pa3); pv_one<DV, 1>(o[1], vb, pa0, pa1, pa2, pa3);
    if constexpr (DV == 128) { pv_one<DV, 2>(o[2], vb, pa0, pa1, pa2, pa3); pv_one<DV, 3>(o[3], vb, pa0, pa1, pa2, pa3); }
}
template <int NKT, int DV> struct Cfg { static constexpr int KB = 8192, VB = 64 * DV * 2, BUF = NKT * KB + VB, SCR = 2 * BUF, TOTAL = SCR + NWAVES * 256; };
template <int NKT, int DV>
__device__ __forceinline__ void attn_unit(const bf16* Qw, const bf16* const (&Kg)[NKT], const bf16* Vg, int ld, int NT, int kidx, LAS unsigned char* lds, f32x16 (&o)[DV / 32], float& l_out) {
    typedef Cfg<NKT, DV> C;
    const int tid = otid(), wid = tid >> 6, lane = tid & 63, r32 = lane & 31, hi = lane >> 5;
    LAS float* al_l = (LAS float*)(lds + C::SCR) + wid * 64;
    float m_reg = -1e30f, l_reg = 0.f;
#pragma unroll
    for (int d = 0; d < DV / 32; ++d) o[d] = f32x16{};
    bf16x8 qr[4];
#pragma unroll
    for (int d0 = 0; d0 < 4; ++d0) qr[d0] = *(const bf16x8*)(Qw + d0 * 16);
    const int krow = tid >> 3, kch = tid & 7, kst = kswz(krow, kch * 16);
    const int vrow = DV == 64 ? (tid >> 3) : (tid >> 4), vcol = DV == 64 ? (tid & 7) * 8 : (tid & 15) * 8;
    const int vst0 = v_st<DV>(vrow, vcol), vst1 = v_st<DV>(32 + vrow, vcol);
    const int vb0 = (int)(uintptr_t)(lds + NKT * C::KB) + v_rd_base(lane);
    struct { bf16x8 k[NKT]; bf16x8 v[DV / 64]; } sr_[2];
#define SLOAD(i, k0) do { _Pragma("unroll") for (int kt = 0; kt < NKT; ++kt) sr_[i].k[kt] = *(const bf16x8*)(Kg[kt] + (size_t)((k0) + krow) * ld + kch * 8); \
        sr_[i].v[0] = *(const bf16x8*)(Vg + (size_t)((k0) + vrow) * ld + vcol); if constexpr (DV == 128) sr_[i].v[1] = *(const bf16x8*)(Vg + (size_t)((k0) + 32 + vrow) * ld + vcol); } while (0)
#define SWRITE(b, i) do { _Pragma("unroll") for (int kt = 0; kt < NKT; ++kt) *(LAS bf16x8*)(lds + (b) * C::BUF + kt * C::KB + kst) = sr_[i].k[kt]; \
        *(LAS bf16x8*)(lds + (b) * C::BUF + NKT * C::KB + vst0) = sr_[i].v[0]; if constexpr (DV == 128) *(LAS bf16x8*)(lds + (b) * C::BUF + NKT * C::KB + vst1) = sr_[i].v[1]; } while (0)
#define SWAIT() do { if constexpr (NKT + DV / 64 == 2) asm volatile("s_waitcnt vmcnt(2)" ::: "memory"); else asm volatile("s_waitcnt vmcnt(4)" ::: "memory"); } while (0)
#define RESC(a) do { if (__any((a) < 1.f)) { if (hi == 0) al_l[r32] = (a); asm volatile("s_waitcnt lgkmcnt(0)" ::: "memory"); \
        _Pragma("unroll") for (int d = 0; d < DV / 32; ++d) _Pragma("unroll") for (int r = 0; r < 16; ++r) o[d][r] *= al_l[crow(r, hi)]; } } while (0)
    f32x16 pA0, pA1, pB0, pB1; float mnA, mnB, alA, alB; bf16x8 pa0, pa1, pa2, pa3;
    LAS const unsigned char* K0 = lds + kidx * C::KB; LAS const unsigned char* K1 = lds + C::BUF + kidx * C::KB;
    SLOAD(0, 0); asm volatile("s_waitcnt vmcnt(0)" ::: "memory"); SWRITE(0, 0); __syncthreads();
    qkt(pA0, pA1, K0, qr, r32, hi); partialSM(pA0, pA1, m_reg, mnA, alA);
    SLOAD(1, 64); if (2 < NT) SLOAD(0, 128);
    SWAIT(); SWRITE(1, 1); __syncthreads();
    for (int j = 1; j + 1 < NT; j += 2) {
        SBAR(); qkt(pB0, pB1, K1, qr, r32, hi);
        finishSM(pA0, pA1, alA, l_reg, pa0, pa1, pa2, pa3); SBAR();
        SLOAD(1, (j + 2) * 64); SBAR();
        pv_all<DV>(o, vb0, pa0, pa1, pa2, pa3); partialSM(pB0, pB1, m_reg, mnB, alB);
        __syncthreads(); SWAIT(); SWRITE(0, 0);
        RESC(alB); __syncthreads();
        SBAR(); qkt(pA0, pA1, K0, qr, r32, hi);
        finishSM(pB0, pB1, alB, l_reg, pa0, pa1, pa2, pa3); SBAR();
        if (j + 3 < NT) SLOAD(0, (j + 3) * 64); SBAR();
        pv_all<DV>(o, vb0 + C::BUF, pa0, pa1, pa2, pa3); partialSM(pA0, pA1, m_reg, mnA, alA);
        __syncthreads(); SWAIT(); SWRITE(1, 1);
        RESC(alA); __syncthreads();
    }
    SBAR(); qkt(pB0, pB1, K1, qr, r32, hi);
    finishSM(pA0, pA1, alA, l_reg, pa0, pa1, pa2, pa3); SBAR();
    pv_all<DV>(o, vb0, pa0, pa1, pa2, pa3); partialSM(pB0, pB1, m_reg, mnB, alB);
    __syncthreads(); RESC(alB);
    finishSM(pB0, pB1, alB, l_reg, pa0, pa1, pa2, pa3); SBAR();
    pv_all<DV>(o, vb0 + C::BUF, pa0, pa1, pa2, pa3);
    l_out = l_reg;
#undef SLOAD
#undef SWRITE
#undef SWAIT
#undef RESC
}
#undef SBAR
}

__device__ __forceinline__ void attn0_unit(const Ptrs& p, LAS unsigned char* lds, int b, int h, int qb  ) {
    const int tid = otid(), wid = tid >> 6, lane = tid & 63, r32 = lane & 31, hi = lane >> 5, kvh = h / 3;
    const bf16* QKV = (const bf16*)(p.ws + WS_BIG);
    const size_t row0 = (size_t)b * TOK + qb * 256 + wid * 32;
    const bf16* Qw = QKV + (row0 + r32) * P0 + h * 64 + hi * 8;
    const bf16* const Kg[1] = {QKV + (size_t)b * TOK * P0 + 768 + kvh * 64};
    const bf16* Vg = QKV + (size_t)b * TOK * P0 + 1024 + kvh * 64;
    att::f32x16 o[2]; float l;
    att::attn_unit<1, 64>(Qw, Kg, Vg, P0, qb == 0 ? CTXL / 64 : TOK / 64, 0, lds, o, l);
    LAS float* li_l = (LAS float*)(lds + att::Cfg<1, 64>::SCR) + wid * 64;
    if (hi == 0) li_l[r32] = l; asm volatile("s_waitcnt lgkmcnt(0)" ::: "memory");
    int lofs = hi * 4 * D + r32; asm volatile("" : "+v"(lofs));
    bf16* Ob = (bf16*)(p.ws + WS_BUFB) + row0 * D + h * 64 + lofs;
#pragma unroll
    for (int r = 0; r < 16; ++r) { const float il = fast_rcp(li_l[att::crow(r, hi)]);
#pragma unroll
        for (int d0 = 0; d0 < 2; ++d0) Ob[((r & 3) + 8 * (r >> 2)) * D + d0 * 32] = (bf16)f2bf(o[d0][r] * il); }
    __syncthreads();
}
__device__ __forceinline__ void pool_chunk(const Ptrs& p, LAS unsigned char* lds, int chunk) {
    const int tid = otid();
    int rbase, n, t0;
    if (chunk < 256) { const int b = chunk / 32; rbase = b * TOK + CTXL; n = SEQ; t0 = (chunk % 32) * 64; }
    else { const int e = chunk - 256, b = e / 4; rbase = b * TOK; n = CTXL; t0 = (e % 4) * 64; }
    const bf16* U = (const bf16*)(p.ws + WS_BIG) + 1280;
    LAS unsigned short* ub = (LAS unsigned short*)lds;
    LAS float* pooled = (LAS float*)(lds + 80 * 512);
    for (int idx = tid; idx < 80 * 32; idx += NTHR) { const int row = idx >> 5, ch = (idx & 31) * 8, s = t0 - 8 + row;
        u32x4 v = {0u, 0u, 0u, 0u}; if (s >= 0 && s < n) v = *(const u32x4*)(U + (size_t)(rbase + s) * P0 + ch);
        *(LAS u32x4*)(ub + row * 256 + ch) = v; }
    __syncthreads();
    { const int c = tid & 255, g = c >> 6, w = 2 << g, half = tid >> 8;
        for (int tt = half * 32; tt < half * 32 + 32; ++tt) { const int t = t0 + tt, lo = max(t - w / 2, 0), hi = min(t + w - w / 2, n); float s = 0.f;
            for (int j = lo; j < hi; ++j) s += bf2f(ub[(j - t0 + 8) * 256 + c]);
            pooled[tt * 260 + c] = s / (float)(hi - lo) - bf2f(ub[(tt + 8) * 256 + c]); } }
    __syncthreads();
    { const int tb = tid >> 5, db = tid & 31, g = db >> 3, d0 = (db & 7) * 8; const float* W = p.ab_w_pool + (size_t)g * 4096 + d0;
        float acc[4][8];
#pragma unroll
        for (int i = 0; i < 4; ++i)
#pragma unroll
            for (int j = 0; j < 8; ++j) acc[i][j] = 0.f;
#pragma unroll 4
        for (int c = 0; c < 64; ++c) { const f32x4 w0 = *(const f32x4*)(W + c * 64), w1 = *(const f32x4*)(W + c * 64 + 4);
#pragma unroll
            for (int i = 0; i < 4; ++i) { const float pv = pooled[(tb * 4 + i) * 260 + g * 64 + c];
#pragma unroll
                for (int j = 0; j < 4; ++j) { acc[i][j] += pv * w0[j]; acc[i][4 + j] += pv * w1[j]; } } }
        const f32x4 s0 = *(const f32x4*)(p.ab_pool_scale + g * 64 + d0), s1 = *(const f32x4*)(p.ab_pool_scale + g * 64 + d0 + 4);
#pragma unroll
        for (int i = 0; i < 4; ++i) { u32x4 o; o.x = pk2(acc[i][0] * s0[0], acc[i][1] * s0[1]); o.y = pk2(acc[i][2] * s0[2], acc[i][3] * s0[3]); o.z = pk2(acc[i][4] * s1[0], acc[i][5] * s1[1]); o.w = pk2(acc[i][6] * s1[2], acc[i][7] * s1[3]);
            *(u32x4*)((bf16*)(p.ws + WS_BUFB) + (size_t)(rbase + t0 + tb * 4 + i) * D + 768 + g * 64 + d0) = o; } }
    __syncthreads();
}
__device__ __forceinline__ void phase_mix0(const Ptrs& p, LAS unsigned char* lds, int vcu) {
    const int x = vcu >> 5, c = vcu & 31;
    for (int i = 0; i < 3; ++i) { const int uidx = i * 32 + c, pair = x * 4 + uidx / 24, w = uidx % 24; attn0_unit(p, lds, pair >> 2, (pair & 3) * 3 + w / 8, 1 + (w & 7)); }
    if (vcu < 96) attn0_unit(p, lds, vcu / 12, vcu % 12, 0);
    for (int ch = vcu; ch < 288; ch += 256) pool_chunk(p, lds, ch);
}

__device__ __forceinline__ void attn1_unit(const Ptrs& p, LAS unsigned char* lds, int b, int h, int qb  , float lam) {
    typedef att::Cfg<2, 128> C;
    const int tid = otid(), wid = tid >> 6, lane = tid & 63, r32 = lane & 31, hi = lane >> 5, comp = wid >> 2, wq = wid & 3;
    const bf16* QKV = (const bf16*)(p.ws + WS_BIG);
    const size_t row0 = (size_t)b * TOK + CTXL + qb * 128 + wq * 32;
    const bf16* Qw = QKV + (row0 + r32) * P1 + (h * 2 + comp) * 64 + hi * 8;
    const bf16* const Kg[2] = {QKV + (size_t)b * TOK * P1 + 768 + (h * 2) * 64, QKV + (size_t)b * TOK * P1 + 768 + (h * 2 + 1) * 64};
    const bf16* Vg = QKV + (size_t)b * TOK * P1 + 1536 + h * 128;
    att::f32x16 o[4]; float l;
    att::attn_unit<2, 128>(Qw, Kg, Vg, P1, TOK / 64, comp, lds, o, l);
    LAS float* li_l = (LAS float*)(lds + C::SCR) + wid * 64;
    if (hi == 0) li_l[r32] = l; asm volatile("s_waitcnt lgkmcnt(0)" ::: "memory");
    LAS float* X = (LAS float*)(lds + C::TOTAL) + wq * 4096;
#pragma unroll
    for (int r = 0; r < 16; ++r) { const float il = fast_rcp(li_l[att::crow(r, hi)]);
#pragma unroll
        for (int d0 = 0; d0 < 4; ++d0) o[d0][r] *= il; }
    if (comp == 1) {
#pragma unroll
        for (int d0 = 0; d0 < 4; ++d0)
#pragma unroll
            for (int r = 0; r < 16; ++r) X[(d0 * 16 + r) * 64 + lane] = o[d0][r];
    }
    __syncthreads();
    if (comp == 0) {
        int lofs = hi * 4 * D + r32; asm volatile("" : "+v"(lofs));
        bf16* Ob = (bf16*)(p.ws + WS_BUFB) + row0 * D + h * 128 + lofs;
        float gsub[4];
#pragma unroll
        for (int d0 = 0; d0 < 4; ++d0) gsub[d0] = p.subln[d0 * 32 + r32];
#pragma unroll
        for (int r = 0; r < 16; ++r) { float ss = 0.f;
#pragma unroll
            for (int d0 = 0; d0 < 4; ++d0) { o[d0][r] -= lam * X[(d0 * 16 + r) * 64 + lane]; ss += o[d0][r] * o[d0][r]; }
            ss += __shfl_xor(ss, 1); ss += __shfl_xor(ss, 2); ss += __shfl_xor(ss, 4); ss += __shfl_xor(ss, 8); ss += __shfl_xor(ss, 16);
            const float rs = (1.f - LAM_INIT) / sqrtf(ss * (1.f / 128.f) + LN_EPS);
#pragma unroll
            for (int d0 = 0; d0 < 4; ++d0) Ob[((r & 3) + 8 * (r >> 2)) * D + d0 * 32] = (bf16)f2bf(o[d0][r] * rs * gsub[d0]); }
    }
    __syncthreads();
}
__device__ __forceinline__ void conv_chunk(const Ptrs& p, LAS unsigned char* lds, int chunk) {
    const int tid = otid(), wave = tid >> 6, lane = tid & 63, b = chunk / 32, t0 = (chunk % 32) * 64;
    const bf16* Z = (const bf16*)(p.ws + WS_BIG) + (size_t)(b * TOK + CTXL) * P1 + 2304;
    LAS unsigned* zb = (LAS unsigned*)lds;
    LAS float* cv = (LAS float*)(lds + 94 * 512);
    for (int idx = tid; idx < 94 * 32; idx += NTHR) { const int row = idx >> 5, ch = (idx & 31) * 8, s = t0 - 15 + row;
        u32x4 v = {0u, 0u, 0u, 0u}; if (s >= 0 && s < SEQ) v = *(const u32x4*)(Z + (size_t)s * P1 + ch);
        *(LAS u32x4*)((LAS unsigned short*)zb + row * 256 + ch) = v; }
    __syncthreads();
    { const int cp = tid & 127, tg = tid >> 7;
        unsigned zw[46];
#pragma unroll
        for (int i = 0; i < 46; ++i) zw[i] = zb[(tg * 16 + i) * 128 + cp];
        float a0[16], a1[16]; const float b0 = p.conv_b[2 * cp], b1 = p.conv_b[2 * cp + 1];
#pragma unroll
        for (int i = 0; i < 16; ++i) { a0[i] = b0; a1[i] = b1; }
#pragma unroll
        for (int j = 0; j < 31; ++j) { const f32x2 w = *(const f32x2*)(p.conv_w + j * 256 + 2 * cp);
#pragma unroll
            for (int i = 0; i < 16; ++i) { const unsigned z = zw[i + j]; a0[i] += __builtin_bit_cast(float, z << 16) * w.x; a1[i] += __builtin_bit_cast(float, z & 0xffff0000u) * w.y; } }
#pragma unroll
        for (int i = 0; i < 16; ++i) *(LAS f32x2*)(cv + (tg * 16 + i) * 256 + 2 * cp) = (f32x2){a0[i], a1[i]}; }
    __syncthreads();
    { const f32x4 g = *(const f32x4*)(p.conv_ln_g + 4 * lane), bb = *(const f32x4*)(p.conv_ln_b + 4 * lane);
        for (int i = 0; i < 8; ++i) { const int tt = wave * 8 + i; f32x4 v = *(LAS f32x4*)(cv + tt * 256 + 4 * lane);
            const float mean = wave_sum((v[0] + v[1]) + (v[2] + v[3])) * (1.f / 256.f); v = v - mean;
            const float rstd = 1.f / sqrtf(wave_sum((v[0] * v[0] + v[1] * v[1]) + (v[2] * v[2] + v[3] * v[3])) * (1.f / 256.f) + LN_EPS);
            v = v * rstd * g + bb; u32x2 o; o.x = pk2(silu_fast(v[0]), silu_fast(v[1])); o.y = pk2(silu_fast(v[2]), silu_fast(v[3]));
            *(u32x2*)((bf16*)(p.ws + WS_BUFB) + (size_t)(b * TOK + CTXL + t0 + tt) * D + 768 + 4 * lane) = o; } }
    __syncthreads();
}
__device__ __forceinline__ void phase_mix1(const Ptrs& p, LAS unsigned char* lds, int vcu) {
    LAS float* lamp = (LAS float*)(lds + LDS_BYTES - 64);
    if (otid() < 64) { const int l = otid(); const float a = wave_sum(p.lq1[l] * p.lk1[l]), c = wave_sum(p.lq2[l] * p.lk2[l]); if (l == 0) lamp[0] = expf(a) - expf(c) + LAM_INIT; }
    __syncthreads();
    const float lam = lamp[0];
    const int x = vcu >> 5, c = vcu & 31;
    for (int i = 0; i < 3; ++i) { const int uidx = i * 32 + c, grp = x * 6 + uidx / 16; attn1_unit(p, lds, grp / 6, grp % 6, uidx & 15, lam); }
    conv_chunk(p, lds, vcu);
}
constexpr int NPHASE = 16;
struct MArgs { Ptrs p; int ph_lo, ph_hi; };
__global__ void __launch_bounds__(NTHR, 2) mega(MArgs a) {
    extern __shared__ __attribute__((aligned(16))) unsigned char lds_raw[];
    LAS unsigned char* lds = (LAS unsigned char*)lds_raw;
    const Ptrs& p = a.p;
    const int tid = otid(), lane = tid & 63, wave = __builtin_amdgcn_readfirstlane(tid >> 6);
    const int G = gridDim.x, bx = blockIdx.x, vcu = (G % 8 == 0) ? (bx % 8) * (G / 8) + bx / 8 : bx;
    const int lo = a.ph_lo, hi = a.ph_hi;
    cg::grid_group grid = cg::this_grid();
#define IN(k) (lo <= (k) && (k) < hi)
#define SEAM(k) do { if (IN(k) && IN((k) + 1)) grid.sync(); } while (0)
    const int NGW = G * NWAVES;
#ifndef NO_PREP
    if (IN(0)) phase_prep(p, lds, vcu, G, tid, wave, lane);
#endif
    SEAM(0);
    if (IN(1)) { const int t1 = otid(); for (int r = vcu * NWAVES + (t1 >> 6); r < R; r += NGW) row_pass(p, r, t1 & 63, 0, nullptr, nullptr, 0, 0); }
    SEAM(1);
    bf16* BUFA = (bf16*)(p.ws + WS_BUFA); bf16* BUFB = (bf16*)(p.ws + WS_BUFB); bf16* BIG = (bf16*)(p.ws + WS_BIG);
    for (int s = 0; s < 14; ++s) {
        const int ph = s + 2, l = s / 7, k = s % 7;
        if (IN(ph)) {
            const int nM = l ? 64 : 72;
            if (k == 0) {
                pg8::Gemm g{BUFA, (const bf16*)(p.ws + (l ? WS_WIN1 : WS_WIN0)), 0, 0, D};
                TileSched S; if (l == 0) S.init(72, 6, G, bx, 0, 0); else S.init(64, 11, G, bx, 1, 48);
                EpiIn E{&p, l};
#ifndef NO_GIN
                pg8::gemm_phase<EpiIn, TileSched, true, true>(lds, g, S, E);
#endif
            } else if (k == 1) {
#ifndef NO_MIX0
                if (l == 0) phase_mix0(p, lds, vcu);
#endif
#ifndef NO_MIX1
                if (l == 1) phase_mix1(p, lds, vcu);
#endif
            } else if (k == 2 || k == 5) {
                pg8::Gemm g{k == 2 ? BUFB : BIG, k == 2 ? (const bf16*)(p.ws + (l ? WS_WOUT1 : WS_WOUT0)) : (const bf16*)(p.ws + WS_WFOUT) + (size_t)l * D * FF, 0, 0, k == 2 ? D : FF};
                TileSched S; S.init(nM, 4, G, bx, l, 0);
                EpiRes E{&p, l, k == 2 ? 2048 : 5120, (k == 2 && l == 0) ? 1 : 0};
#ifndef NO_GRES
                pg8::gemm_phase<EpiRes, TileSched, true, true>(lds, g, S, E);
#endif
            } else if (k == 4) {
                pg8::Gemm g{BUFA, (const bf16*)(p.ws + WS_WFIN) + (size_t)l * 2 * FF * D, 0, 0, D};
                TileSched S; S.init(nM, 22, G, bx, l, 0);
                EpiFfn E{BIG};
#ifndef NO_GFFN
                pg8::gemm_phase<EpiFfn, TileSched, true, true>(lds, g, S, E);
#endif
            } else {
                const float* lg = (k == 3 ? p.ln1_g : p.ln2_g) + l * D; const float* lb = (k == 3 ? p.ln1_b : p.ln2_b) + l * D;
                const int hlayer = k == 3 ? l : l + 1, hoff = k == 3 ? 3072 : (l == 0 ? 0 : -1), nrows = l ? NB * SEQ : R;
                const int t1 = otid();
                for (int i = vcu * NWAVES + (t1 >> 6); i < nrows; i += NGW) { const int r = l ? (i / SEQ) * TOK + CTXL + i % SEQ : i; row_pass(p, r, t1 & 63, 1, lg, lb, hlayer, hoff); }
            }
        }
        SEAM(ph);
    }
#undef IN
#undef SEAM
}

#ifndef STAGES
#define STAGES "MMMMMMMMMMMMMMMM"
#endif
static void launch_naive(const Ptrs& p, int ph, hipStream_t stream) {
    bf16* BUFA = (bf16*)(p.ws + WS_BUFA); bf16* BUFB = (bf16*)(p.ws + WS_BUFB); bf16* BIG = (bf16*)(p.ws + WS_BIG);
    if (ph == 0) { n_prep<<<(2 * 9 * MODW + 1024 + 255) / 256, 256, 0, stream>>>(p); return; }
    if (ph == 1) { n_rowpass<<<1024, 256, 0, stream>>>(p, 0, 0, nullptr, nullptr, 0, 0); return; }
    const int l = (ph - 2) / 7, k = (ph - 2) % 7, rm = l ? 1 : 0, nrt = (l ? NB * SEQ : R) / 64;
    switch (k) {
    case 0: if (l == 0) { NG g = mk(BUFA, D, p.ab_w_in, P0, 0, EPI_IN0, 0, 0, 0, 0, BIG); n_gemm<<<dim3(24, nrt), 256, 0, stream>>>(p, g); }
            else { NG g = mk(BUFA, D, p.cd_w_in, CIN1, 1, EPI_IN1, 1, 0, 0, 0, BIG); n_gemm<<<dim3(40, nrt), 256, 0, stream>>>(p, g);
                   NG g2 = mk(BUFA, D, p.cd_w_in, CIN1, 2, EPI_IN1, 1, 12, 0, 0, BIG); n_gemm<<<dim3(24, NB * CTXL / 64), 256, 0, stream>>>(p, g2); } break;
    case 1: if (l == 0) { n_attn0<<<dim3(9, 12, NB), 256, 0, stream>>>(p); n_pool<<<R, 256, 0, stream>>>(p); }
            else { n_attn1<<<dim3(32, 6, NB), 256, 0, stream>>>(p); n_conv<<<NB * SEQ, 256, 0, stream>>>(p); } break;
    case 2: { NG g = mk(BUFB, D, l ? p.cd_w_out : p.ab_w_out, D, rm, EPI_RES, l, 0, l == 0, 2048, nullptr); n_gemm<<<dim3(16, nrt), 256, 0, stream>>>(p, g); } break;
    case 3: n_rowpass<<<1024, 256, 0, stream>>>(p, 1, rm, p.ln1_g + l * D, p.ln1_b + l * D, l, 3072); break;
    case 4: { NG g = mk(BUFA, D, p.ffn_w_in + (size_t)l * D * 2 * FF, 2 * FF, rm, EPI_FFN, l, 0, 0, 0, BIG); n_gemm<<<dim3(FF / 64, nrt), 256, 0, stream>>>(p, g); } break;
    case 5: { NG g = mk(BIG, FF, p.ffn_w_out + (size_t)l * FF * D, D, rm, EPI_RES, l, 0, 0, 5120, nullptr); n_gemm<<<dim3(16, nrt), 256, 0, stream>>>(p, g); } break;
    case 6: n_rowpass<<<1024, 256, 0, stream>>>(p, 1, rm, p.ln2_g + l * D, p.ln2_b + l * D, l + 1, l == 0 ? 0 : -1); break;
    }
}
extern "C" void kernel_launch(void* const* d_in, const int* in_sizes, int n_in, void* d_out, int out_size, void* d_ws, size_t ws_size, hipStream_t stream) {
    if (n_in != 29 || in_sizes[0] != NB * SEQ * D || out_size != NB * SEQ * D || ws_size < WS_END) { fprintf(stderr, "kernel_launch: unexpected shapes (n_in %d, ws %zu)\n", n_in, ws_size); return; }
    static int grid = 0;
    if (grid == 0) {
        int dev = 0, cus = 0, per_cu = 0;
        (void)hipGetDevice(&dev); (void)hipDeviceGetAttribute(&cus, hipDeviceAttributeMultiprocessorCount, dev);
        if (hipFuncSetAttribute((const void*)mega, hipFuncAttributeMaxDynamicSharedMemorySize, LDS_BYTES) != hipSuccess) { fprintf(stderr, "kernel_launch: hipFuncSetAttribute failed\n"); grid = -1; return; }
        (void)hipOccupancyMaxActiveBlocksPerMultiprocessor(&per_cu, (const void*)mega, NTHR, LDS_BYTES);
        if (per_cu < 1) { fprintf(stderr, "kernel_launch: occupancy query says %d blocks per CU\n", per_cu); grid = -1; return; }
        grid = cus;
        fprintf(stderr, "kernel_launch: %d CUs, occupancy %d per CU, grid %d\n", cus, per_cu, grid);
    }
    if (grid < 0) return;
    MArgs a; memset(&a, 0, sizeof(a));
    const float** f = (const float**)&a.p;
    for (int i = 0; i < 29; ++i) f[i] = (const float*)d_in[i];
    a.p.out = (float*)d_out; a.p.ws = (unsigned char*)d_ws;
    const char* st = STAGES;
    for (int ph = 0; ph < NPHASE;) {
        if (st[ph] == 'N') { launch_naive(a.p, ph, stream); ++ph; continue; }
        int e = ph; while (e < NPHASE && st[e] == 'M') ++e;
        a.ph_lo = ph; a.ph_hi = e;
        void* args[] = {&a};
        hipError_t err = hipLaunchCooperativeKernel((const void*)mega, dim3(grid), dim3(NTHR), args, LDS_BYTES, stream);
        if (err != hipSuccess) fprintf(stderr, "kernel_launch: cooperative launch failed: %s (grid %d)\n", hipGetErrorString(err), grid);
        ph = e;
    }
}
```

```cpp
#include <hip/hip_runtime.h>
#include <cstdio>
#include <cstdint>
#include <cmath>
#include <cstring>
#include <hip/hip_cooperative_groups.h>
namespace cg = cooperative_groups;

constexpr int D = 1024, NB = 8, SEQ = 2048, CTXL = 256, TOK = SEQ + CTXL, R = NB * TOK;
constexpr int FF = 2816, HD = 64;
constexpr int P0 = 1536;
constexpr int P1 = 2560;
constexpr int CIN1 = 2816;
constexpr float ALPHA = 1.4142135623730951f, LN_EPS = 1e-6f;
constexpr float QSCALE = 0.125f * 1.4426950408889634f;
constexpr float LAM_INIT = 0.35550906758f;
constexpr int MODW = 6 * D;

constexpr size_t MiB = 1u << 20;
constexpr size_t WS_CTL = 0, WS_MOD = 1 * MiB, WS_ROPE = WS_MOD + 2 * 9 * MODW * 4;
constexpr size_t WS_XC = 48 * MiB, WS_BUFA = 56 * MiB, WS_BUFB = 92 * MiB, WS_BIG = 128 * MiB, WS_END = 227 * MiB;
static_assert(WS_ROPE + 2 * 64 * 16 * 4 <= 2 * MiB, "ws map");

typedef unsigned short bf16;
__device__ __forceinline__ unsigned f2bf(float f) { unsigned u = __builtin_bit_cast(unsigned, f); return (u + 0x7fffu + ((u >> 16) & 1u)) >> 16; }
__device__ __forceinline__ float bf2f(unsigned short h) { return __builtin_bit_cast(float, (unsigned)h << 16); }
__device__ __forceinline__ float silu_f(float x) { return x / (1.f + __expf(-x)); }
__device__ __forceinline__ float sigmoid_f(float x) { return 1.f / (1.f + __expf(-x)); }

struct Ptrs {
    const float *x, *c, *ctx, *c_ctx, *ab_w_in, *ab_q_gain, *ab_k_gain, *ab_w_pool, *ab_pool_scale, *ab_w_out,
        *cd_w_in, *lq1, *lk1, *lq2, *lk2, *subln, *conv_w, *conv_b, *conv_ln_g, *conv_ln_b, *cd_w_out,
        *ada_w, *ada_b, *ln1_g, *ln1_b, *ln2_g, *ln2_b, *ffn_w_in, *ffn_w_out;
    float* out; unsigned char* ws;
};
__device__ __forceinline__ float* res_row(const Ptrs& p, int r) {
    const int b = r / TOK, tp = r % TOK;
    return tp < CTXL ? (float*)(p.ws + WS_XC) + (size_t)(b * CTXL + tp) * D : p.out + (size_t)(b * SEQ + tp - CTXL) * D;
}
__device__ __forceinline__ const float* in_row(const Ptrs& p, int r) {
    const int b = r / TOK, tp = r % TOK;
    return tp < CTXL ? p.ctx + (size_t)(b * CTXL + tp) * D : p.x + (size_t)(b * SEQ + tp - CTXL) * D;
}
__device__ __forceinline__ const float* mod_vec(const Ptrs& p, int layer, int r) {
    const int b = r / TOK, tp = r % TOK;
    return (const float*)(p.ws + WS_MOD) + (size_t)(layer * 9 + (tp < CTXL ? 8 : b)) * MODW;
}

__global__ void n_prep(Ptrs p) {
    const int gid = blockIdx.x * blockDim.x + threadIdx.x;
    if (gid < 2 * 9 * MODW) {
        const int l = gid / (9 * MODW), v = (gid / MODW) % 9, j = gid % MODW;
        const float* cv = v < 8 ? p.c + v * D : p.c_ctx; const float* W = p.ada_w + (size_t)l * D * MODW;
        float acc = 0.f;
        for (int k = 0; k < D; ++k) acc += silu_f(cv[k]) * W[(size_t)k * MODW + j];
        ((float*)(p.ws + WS_MOD))[gid] = acc + p.ada_b[l * MODW + j];
    } else if (gid < 2 * 9 * MODW + 1024) {
        const int e = gid - 2 * 9 * MODW, pos = e / 16, i = e % 16;
        const double fr = pow(10000.0, -(2.0 * i) / 32.0), ang = (double)pos * fr;
        float* rope = (float*)(p.ws + WS_ROPE); rope[e] = (float)cos(ang); rope[1024 + e] = (float)sin(ang);
    }
}

__device__ __forceinline__ float wave_sum(float v) {
#pragma unroll
    for (int o = 1; o < 64; o <<= 1) v += __shfl_xor(v, o);
    return v;
}
__device__ __forceinline__ void row_pass(const Ptrs& p, int r, int lane, int mode, const float* lng, const float* lnb, int hlayer, int hoff) {
    float4 v[4];
    const float4* src = (const float4*)(mode == 0 ? in_row(p, r) : res_row(p, r));
#pragma unroll
    for (int j = 0; j < 4; ++j) v[j] = src[lane + 64 * j];
    if (mode == 1) {
        float s = 0.f;
#pragma unroll
        for (int j = 0; j < 4; ++j) s += (v[j].x + v[j].y) + (v[j].z + v[j].w);
        const float mean = wave_sum(s) * (1.f / D); float q = 0.f;
#pragma unroll
        for (int j = 0; j < 4; ++j) { v[j].x -= mean; v[j].y -= mean; v[j].z -= mean; v[j].w -= mean; q += (v[j].x * v[j].x + v[j].y * v[j].y) + (v[j].z * v[j].z + v[j].w * v[j].w); }
        const float rstd = 1.f / sqrtf(wave_sum(q) * (1.f / D) + LN_EPS);
        float4* dst = (float4*)res_row(p, r);
#pragma unroll
        for (int j = 0; j < 4; ++j) { const float4 g = ((const float4*)lng)[lane + 64 * j], b = ((const float4*)lnb)[lane + 64 * j];
            v[j].x = v[j].x * rstd * g.x + b.x; v[j].y = v[j].y * rstd * g.y + b.y; v[j].z = v[j].z * rstd * g.z + b.z; v[j].w = v[j].w * rstd * g.w + b.w; dst[lane + 64 * j] = v[j]; }
    }
    if (hoff >= 0) {
        const float* mv = mod_vec(p, hlayer, r); const float4* sh = (const float4*)(mv + hoff); const float4* sc = (const float4*)(mv + hoff + D);
        uint2* dst = (uint2*)((bf16*)(p.ws + WS_BUFA) + (size_t)r * D);
#pragma unroll
        for (int j = 0; j < 4; ++j) { const float4 a = sh[lane + 64 * j], s = sc[lane + 64 * j];
            const float h0 = v[j].x * (1.f + s.x) + a.x, h1 = v[j].y * (1.f + s.y) + a.y, h2 = v[j].z * (1.f + s.z) + a.z, h3 = v[j].w * (1.f + s.w) + a.w;
            dst[lane + 64 * j] = make_uint2(f2bf(h0) | (f2bf(h1) << 16), f2bf(h2) | (f2bf(h3) << 16)); }
    }
}
__global__ __launch_bounds__(256) void n_rowpass(Ptrs p, int mode, int latent_only, const float* lng, const float* lnb, int hlayer, int hoff) {
    const int gw = (blockIdx.x * 256 + threadIdx.x) >> 6, lane = threadIdx.x & 63, nw = (gridDim.x * 256) >> 6;
    const int nrows = latent_only ? NB * SEQ : R;
    for (int i = gw; i < nrows; i += nw) { const int r = latent_only ? (i / SEQ) * TOK + CTXL + i % SEQ : i; row_pass(p, r, lane, mode, lng, lnb, hlayer, hoff); }
}

enum { EPI_IN0 = 0, EPI_IN1 = 1, EPI_RES = 2, EPI_FFN = 3 };
struct NG { const bf16* A; const float* W; bf16* O; int K, ldw, rowmode  , epi, layer, tn0  , resid_in_is_input, gate_off; };
static NG mk(const bf16* A, int K, const float* W, int ldw, int rowmode, int epi, int layer, int tn0, int rin, int gate_off, bf16* O) {
    NG g; memset(&g, 0, sizeof(g)); g.A = A; g.W = W; g.O = O; g.K = K; g.ldw = ldw; g.rowmode = rowmode; g.epi = epi; g.layer = layer; g.tn0 = tn0; g.resid_in_is_input = rin; g.gate_off = gate_off; return g; }
__global__ __launch_bounds__(256) void n_gemm(Ptrs p, NG g) {
    __shared__ float As[16][68]; __shared__ float Ws[16][64]; __shared__ float Ws2[16][64]; __shared__ float Out[64][65]; __shared__ float Out2[64][65];
    const int tid = threadIdx.x, ty = tid >> 4, tx = tid & 15, tm = blockIdx.y, tn = blockIdx.x + g.tn0;
    int row0;
    if (g.rowmode == 0) row0 = tm * 64; else if (g.rowmode == 1) row0 = (tm / 32) * TOK + CTXL + (tm % 32) * 64; else row0 = (tm / 4) * TOK + (tm % 4) * 64;
    int c0 = tn * 64, c1 = -1;
    if (g.epi == EPI_FFN) { c1 = FF + tn * 64; }
    if (g.epi == EPI_IN1 && tn >= 36) { c0 = 2304 + (tn - 36) * 64; c1 = 2560 + (tn - 36) * 64; }
    const bool dual = c1 >= 0;
    float acc[4][4] = {}, acc2[4][4] = {};
    for (int k0 = 0; k0 < g.K; k0 += 16) {
        { const int rr = tid >> 2, kk = (tid & 3) * 4; const uint2 a = *(const uint2*)(g.A + (size_t)(row0 + rr) * g.K + k0 + kk);
          As[kk + 0][rr] = bf2f(a.x & 0xffff); As[kk + 1][rr] = bf2f(a.x >> 16); As[kk + 2][rr] = bf2f(a.y & 0xffff); As[kk + 3][rr] = bf2f(a.y >> 16); }
        { const int kk = tid >> 4, cc = (tid & 15) * 4; *(float4*)&Ws[kk][cc] = *(const float4*)(g.W + (size_t)(k0 + kk) * g.ldw + c0 + cc);
          if (dual) *(float4*)&Ws2[kk][cc] = *(const float4*)(g.W + (size_t)(k0 + kk) * g.ldw + c1 + cc); }
        __syncthreads();
#pragma unroll
        for (int kk = 0; kk < 16; ++kk) {
            float a[4], w[4], w2[4];
#pragma unroll
            for (int i = 0; i < 4; ++i) { a[i] = As[kk][ty * 4 + i]; w[i] = Ws[kk][tx * 4 + i]; w2[i] = dual ? Ws2[kk][tx * 4 + i] : 0.f; }
#pragma unroll
            for (int i = 0; i < 4; ++i)
#pragma unroll
                for (int j = 0; j < 4; ++j) { acc[i][j] += a[i] * w[j]; acc2[i][j] += a[i] * w2[j]; }
        }
        __syncthreads();
    }
#pragma unroll
    for (int i = 0; i < 4; ++i)
#pragma unroll
        for (int j = 0; j < 4; ++j) { Out[ty * 4 + i][tx * 4 + j] = acc[i][j]; Out2[ty * 4 + i][tx * 4 + j] = acc2[i][j]; }
    __syncthreads();
    const float* rope = (const float*)(p.ws + WS_ROPE);
    if (g.epi == EPI_RES) {
        for (int e = tid; e < 64 * 64; e += 256) { const int rr = e >> 6, cc = e & 63, r = row0 + rr, c = c0 + cc;
            const float xin = g.resid_in_is_input ? in_row(p, r)[c] : res_row(p, r)[c];
            res_row(p, r)[c] = ALPHA * xin + mod_vec(p, g.layer, r)[g.gate_off + c] * Out[rr][cc]; }
    } else if (g.epi == EPI_FFN) {
        for (int e = tid; e < 64 * 64; e += 256) { const int rr = e >> 6, cc = e & 63;
            g.O[(size_t)(row0 + rr) * FF + c0 + cc] = (bf16)f2bf(silu_f(Out2[rr][cc]) * Out[rr][cc]); }
    } else if (dual) {
        for (int e = tid; e < 64 * 64; e += 256) { const int rr = e >> 6, cc = e & 63;
            g.O[(size_t)(row0 + rr) * P1 + 2304 + (tn - 36) * 64 + cc] = (bf16)f2bf(Out[rr][cc] * sigmoid_f(Out2[rr][cc])); }
    } else if (tid < 64) {
        const int rr = tid, r = row0 + rr, tp = r % TOK; const bool lat = tp >= CTXL; const int t = tp - CTXL;
        int kind; const float* gain = nullptr; int pitch;
        if (g.epi == EPI_IN0) { pitch = P0; kind = tn < 12 ? 0 : (tn < 16 ? 1 : 2); gain = tn < 12 ? p.ab_q_gain : p.ab_k_gain; }
        else { pitch = P1; kind = tn < 12 ? 0 : (tn < 24 ? 1 : 2); }
        float v[64];
#pragma unroll
        for (int d = 0; d < 64; ++d) v[d] = Out[rr][d];
        if (kind < 2) {
            if (g.epi == EPI_IN0) { float ss = 0.f;
#pragma unroll
                for (int d = 0; d < 64; ++d) ss += v[d] * v[d];
                const float rs = 1.f / sqrtf(ss * (1.f / 64.f) + LN_EPS);
#pragma unroll
                for (int d = 0; d < 64; ++d) v[d] = v[d] * rs * gain[d]; }
            if (lat) {
                const int prow = t / 64, pcol = t % 64;
#pragma unroll
                for (int i = 0; i < 16; ++i) {
                    { const float c = rope[prow * 16 + i], s = rope[1024 + prow * 16 + i], x1 = v[i], x2 = v[16 + i]; v[i] = x1 * c - x2 * s; v[16 + i] = x2 * c + x1 * s; }
                    { const float c = rope[pcol * 16 + i], s = rope[1024 + pcol * 16 + i], x1 = v[32 + i], x2 = v[48 + i]; v[32 + i] = x1 * c - x2 * s; v[48 + i] = x2 * c + x1 * s; }
                }
            }
            if (kind == 0) {
#pragma unroll
                for (int d = 0; d < 64; ++d) v[d] *= QSCALE; }
        }
        bf16* o = g.O + (size_t)r * pitch + tn * 64;
#pragma unroll
        for (int d = 0; d < 64; ++d) o[d] = (bf16)f2bf(v[d]);
    }
}

__global__ __launch_bounds__(256) void n_attn0(Ptrs p) {
    const int b = blockIdx.z, h = blockIdx.y, ch = blockIdx.x, kvh = h / 3;
    const bf16* QKV = (const bf16*)(p.ws + WS_BIG);
    const int r = b * TOK + ch * 256 + threadIdx.x, nkeys = ch == 0 ? CTXL : TOK;
    float q[64], o[64];
    { const bf16* qp = QKV + (size_t)r * P0 + h * 64;
#pragma unroll
      for (int d = 0; d < 64; ++d) { q[d] = bf2f(qp[d]); o[d] = 0.f; } }
    float m = -1e30f, l = 0.f;
    for (int j = 0; j < nkeys; ++j) {
        const bf16* kp = QKV + (size_t)(b * TOK + j) * P0 + 768 + kvh * 64; const bf16* vp = kp + 256;
        float s = 0.f;
#pragma unroll
        for (int d = 0; d < 64; ++d) s += q[d] * bf2f(kp[d]);
        const float mn = fmaxf(m, s), a = exp2f(m - mn), pp = exp2f(s - mn);
        l = l * a + pp; m = mn;
#pragma unroll
        for (int d = 0; d < 64; ++d) o[d] = o[d] * a + pp * bf2f(vp[d]);
    }
    bf16* op = (bf16*)(p.ws + WS_BUFB) + (size_t)r * D + h * 64; const float il = 1.f / l;
#pragma unroll
    for (int d = 0; d < 64; ++d) op[d] = (bf16)f2bf(o[d] * il);
}
__global__ __launch_bounds__(256) void n_pool(Ptrs p) {
    __shared__ float pooled[256];
    const int r = blockIdx.x, tp = r % TOK, c = threadIdx.x, g = c >> 6; const bool lat = tp >= CTXL;
    const int t = lat ? tp - CTXL : tp, n = lat ? SEQ : CTXL, rbase = r - t;
    const bf16* U = (const bf16*)(p.ws + WS_BIG) + 1280;
    const int w = 2 << g, lo = max(t - w / 2, 0), hi = min(t + w - w / 2, n);
    float s = 0.f;
    for (int j = lo; j < hi; ++j) s += bf2f(U[(size_t)(rbase + j) * P0 + c]);
    pooled[c] = s / (float)(hi - lo) - bf2f(U[(size_t)r * P0 + c]);
    __syncthreads();
    const int d = c & 63; const float* W = p.ab_w_pool + (size_t)g * 64 * 64;
    float acc = 0.f;
    for (int cc = 0; cc < 64; ++cc) acc += pooled[g * 64 + cc] * W[cc * 64 + d];
    ((bf16*)(p.ws + WS_BUFB))[(size_t)r * D + 768 + c] = (bf16)f2bf(acc * p.ab_pool_scale[c]);
}
__global__ __launch_bounds__(256) void n_attn1(Ptrs p) {
    __shared__ float lam_s;
    const int b = blockIdx.z, h = blockIdx.y, qi = threadIdx.x >> 2, qt = threadIdx.x & 3;
    if (threadIdx.x == 0) { float a = 0.f, c = 0.f; for (int i = 0; i < 64; ++i) { a += p.lq1[i] * p.lk1[i]; c += p.lq2[i] * p.lk2[i]; } lam_s = expf(a) - expf(c) + LAM_INIT; }
    __syncthreads();
    const float lam = lam_s;
    const bf16* QKV = (const bf16*)(p.ws + WS_BIG);
    const int r = b * TOK + CTXL + blockIdx.x * 64 + qi;
    float on[2][32];
#pragma unroll
    for (int comp = 0; comp < 2; ++comp) {
        float q[64], o[32];
        { const bf16* qp = QKV + (size_t)r * P1 + (h * 2 + comp) * 64;
#pragma unroll
          for (int d = 0; d < 64; ++d) q[d] = bf2f(qp[d]);
#pragma unroll
          for (int d = 0; d < 32; ++d) o[d] = 0.f; }
        float m = -1e30f, l = 0.f;
        for (int j = 0; j < TOK; ++j) {
            const bf16* kp = QKV + (size_t)(b * TOK + j) * P1 + 768 + (h * 2 + comp) * 64; const bf16* vp = QKV + (size_t)(b * TOK + j) * P1 + 1536 + h * 128 + qt * 32;
            float s = 0.f;
#pragma unroll
            for (int d = 0; d < 64; ++d) s += q[d] * bf2f(kp[d]);
            const float mn = fmaxf(m, s), a = exp2f(m - mn), pp = exp2f(s - mn);
            l = l * a + pp; m = mn;
#pragma unroll
            for (int d = 0; d < 32; ++d) o[d] = o[d] * a + pp * bf2f(vp[d]);
        }
        const float il = 1.f / l;
#pragma unroll
        for (int d = 0; d < 32; ++d) on[comp][d] = o[d] * il;
    }
    float ss = 0.f, df[32];
#pragma unroll
    for (int d = 0; d < 32; ++d) { df[d] = on[0][d] - lam * on[1][d]; ss += df[d] * df[d]; }
    ss += __shfl_xor(ss, 1); ss += __shfl_xor(ss, 2);
    const float rs = 1.f / sqrtf(ss * (1.f / 128.f) + LN_EPS) * (1.f - LAM_INIT);
    bf16* op = (bf16*)(p.ws + WS_BUFB) + (size_t)r * D + h * 128 + qt * 32;
#pragma unroll
    for (int d = 0; d < 32; ++d) op[d] = (bf16)f2bf(df[d] * rs * p.subln[qt * 32 + d]);
}
__global__ __launch_bounds__(256) void n_conv(Ptrs p) {
    __shared__ float red[8];
    const int b = blockIdx.x / SEQ, t = blockIdx.x % SEQ, c = threadIdx.x, r = b * TOK + CTXL + t;
    const bf16* Z = (const bf16*)(p.ws + WS_BIG) + 2304;
    float acc = p.conv_b[c];
    for (int j = 0; j < 31; ++j) { const int tt = t + j - 15; if (tt >= 0 && tt < SEQ) acc += bf2f(Z[(size_t)(b * TOK + CTXL + tt) * P1 + c]) * p.conv_w[j * 256 + c]; }
    float s = wave_sum(acc); if ((c & 63) == 0) red[c >> 6] = s; __syncthreads();
    const float mean = (red[0] + red[1] + red[2] + red[3]) * (1.f / 256.f); const float dv = acc - mean;
    float q = wave_sum(dv * dv); if ((c & 63) == 0) red[4 + (c >> 6)] = q; __syncthreads();
    const float rstd = 1.f / sqrtf((red[4] + red[5] + red[6] + red[7]) * (1.f / 256.f) + LN_EPS);
    const float y = dv * rstd * p.conv_ln_g[c] + p.conv_ln_b[c];
    ((bf16*)(p.ws + WS_BUFB))[(size_t)r * D + 768 + c] = (bf16)f2bf(silu_f(y));
}

__device__ __forceinline__ int otid() { int t = threadIdx.x; asm volatile("" : "+v"(t)); return t; }
namespace pg8 {
#define PG8_LAS __attribute__((address_space(3)))
typedef unsigned short bf16_t;
typedef short bf16x8 __attribute__((ext_vector_type(8)));
typedef float f32x4 __attribute__((ext_vector_type(4)));
typedef unsigned u32x4 __attribute__((ext_vector_type(4)));
constexpr int BM = 256, BK = 64, HALF = 128, HTB = HALF * BK * 2  , STAGE_BYTES = 8 * HTB, NXCD = 8, WGM = 8;

__host__ __device__ __forceinline__ int lds_byte(int r, int c) { const int st = (r >> 4) * 2 + (c >> 5), rr = r & 15, cc = c & 31, ob = rr * 64 + cc * 2; return st * 1024 + (ob ^ (((ob >> 9) & 1) << 5)); }
__host__ __device__ __forceinline__ void stage_rc(int b, int& R, int& C) { const int st = b / 1024, sb = b % 1024, swz = sb ^ (((sb >> 9) & 1) << 5); R = (st >> 1) * 16 + swz / 64; C = (st & 1) * 32 + (swz % 64) / 2; }
__host__ __device__ __forceinline__ int perm32(int rho) { const int n = rho >> 4, i = rho & 15; return 8 * (i >> 2) + 4 * n + (i & 3); }

struct Unit { int pm, pn; };
struct Gemm { const bf16_t* A; const bf16_t* Bt; int M, N, K; };

__device__ __forceinline__ unsigned cvt_pk_bf16(float lo, float hi) { unsigned r; asm volatile("v_cvt_pk_bf16_f32 %0, %1, %2" : "=v"(r) : "v"(lo), "v"(hi)); return r; }
typedef float f32x2 __attribute__((ext_vector_type(2)));

template <class Epi, class Sched, bool ALIGN_EPI = false, bool SP2 = false>
__device__ __forceinline__ void gemm_phase(PG8_LAS unsigned char* lds, const Gemm g, const Sched& S, const Epi& E) {
    const int tid = otid(), wid = __builtin_amdgcn_readfirstlane(tid >> 6), lane = tid & 63, wr = wid >> 2, wc = wid & 3, fr = lane & 15, fq = lane >> 4;
    const int K = g.K, nt = K / BK;
    unsigned voffA[2], voffB[2];
#pragma unroll
    for (int i = 0; i < 2; ++i) { int R, C; stage_rc(tid * 16 + i * 8192, R, C); const int Rb = Epi::PERM ? ((R & ~31) + perm32(R & 31)) : R;
        voffA[i] = (unsigned)(R * K + C) * 2u; voffB[i] = (unsigned)(Rb * K + C) * 2u; }
    const size_t kstep = (size_t)(BK * 2);
    const size_t hstep = (size_t)HALF * K * 2;
    const size_t tstep = 2 * hstep;
    const unsigned ldsw = (unsigned)wid * 1024u;
    const int aoff = lds_byte(wr * 64 + fr, fq * 8), boff = lds_byte(wc * 32 + fr, fq * 8);
#define PG8_SA(b, h) (((b) * 2 + (h)) * HTB)
#define PG8_SB(b, h) ((4 + (b) * 2 + (h)) * HTB)
#define PG8_STAGE(bufoff, gbase, voff) do { _Pragma("unroll") for (int _i = 0; _i < 2; ++_i) \
        __builtin_amdgcn_global_load_lds((const unsigned*)((const char*)(gbase) + (voff)[_i]), (PG8_LAS unsigned*)(lds + (bufoff) + ldsw + _i * 8192), 16, 0, 0); } while (0)
#define PG8_LDA(dst, b, h) do { _Pragma("unroll") for (int m = 0; m < 4; ++m) _Pragma("unroll") for (int k = 0; k < 2; ++k) dst[m][k] = *(const PG8_LAS bf16x8*)(lds + PG8_SA(b, h) + aoff + m * 2048 + k * 1024); } while (0)
#define PG8_LDB(dst, b, h) do { _Pragma("unroll") for (int n = 0; n < 2; ++n) _Pragma("unroll") for (int k = 0; k < 2; ++k) dst[n][k] = *(const PG8_LAS bf16x8*)(lds + PG8_SB(b, h) + boff + n * 2048 + k * 1024); } while (0)
#define PG8_MMA(ai, bj, At, Bt) do { __builtin_amdgcn_s_setprio(1); _Pragma("unroll") for (int m = 0; m < 4; ++m) _Pragma("unroll") for (int n = 0; n < 2; ++n) _Pragma("unroll") for (int k = 0; k < 2; ++k) \
        acc[ai][bj][m][n] = __builtin_amdgcn_mfma_f32_16x16x32_bf16(Bt[n][k], At[m][k], acc[ai][bj][m][n], 0, 0, 0); __builtin_amdgcn_s_setprio(0); } while (0)
#define PG8_WAIT_V(n) asm volatile("s_waitcnt vmcnt(" #n ")" ::: "memory")
#define PG8_WAIT_L(n) asm volatile("s_waitcnt lgkmcnt(" #n ")" ::: "memory")
#define PG8_BAR __builtin_amdgcn_s_barrier()
#define PG8_SCHED __builtin_amdgcn_sched_barrier(0)
    Unit cur, nxt; int ui = 0;
    if (!S.next(0, cur)) return;
    f32x4 acc[2][2][4][2];
#pragma unroll
    for (int a = 0; a < 2; ++a)
#pragma unroll
        for (int b = 0; b < 2; ++b)
#pragma unroll
            for (int m = 0; m < 4; ++m)
#pragma unroll
                for (int n = 0; n < 2; ++n) acc[a][b][m][n] = (f32x4){0.f, 0.f, 0.f, 0.f};
    bf16x8 At[4][2], B0[2][2], B1[2][2];
    const char* cA = (const char*)g.A + (size_t)cur.pm * tstep; const char* cB = (const char*)g.Bt + (size_t)cur.pn * tstep;
    S.a_ready(cur);
    if constexpr (SP2) {
        PG8_STAGE(PG8_SB(0, 0), cB, voffB); PG8_STAGE(PG8_SB(0, 1), cB + hstep, voffB); PG8_STAGE(PG8_SA(0, 0), cA, voffA); PG8_STAGE(PG8_SA(0, 1), cA + hstep, voffA);
        if (wr == 1) PG8_BAR;
        PG8_WAIT_V(2); PG8_BAR;
        PG8_STAGE(PG8_SB(1, 0), cB + kstep, voffB); PG8_STAGE(PG8_SA(1, 0), cA + kstep, voffA); PG8_STAGE(PG8_SB(1, 1), cB + hstep + kstep, voffB);
        PG8_WAIT_V(6); PG8_BAR;
    } else {
        PG8_STAGE(PG8_SB(0, 0), cB, voffB); PG8_STAGE(PG8_SA(0, 0), cA, voffA); PG8_STAGE(PG8_SB(0, 1), cB + hstep, voffB); PG8_STAGE(PG8_SA(0, 1), cA + hstep, voffA);
        if (wr == 1) PG8_BAR;
        PG8_WAIT_V(4); PG8_BAR;
        PG8_STAGE(PG8_SB(1, 0), cB + kstep, voffB); PG8_STAGE(PG8_SA(1, 0), cA + kstep, voffA); PG8_STAGE(PG8_SB(1, 1), cB + hstep + kstep, voffB);
        PG8_WAIT_V(6); PG8_BAR;
    }
    for (;;) {
        const bool has_next = S.next(ui + 1, nxt);
        const char* nA = has_next ? (const char*)g.A + (size_t)nxt.pm * tstep : cA; const char* nB = has_next ? (const char*)g.Bt + (size_t)nxt.pn * tstep : cB;
        for (int t = 0; t < nt; t += 2) {
            const bool last = (t == nt - 2);
            const char* a1 = cA + (size_t)(t + 1) * kstep;
            const char* a2 = last ? nA : cA + (size_t)(t + 2) * kstep; const char* b2 = last ? nB : cB + (size_t)(t + 2) * kstep;
            const char* a3 = a2 + kstep; const char* b3 = b2 + kstep;
            if (last && has_next) S.a_ready(nxt);
            if constexpr (SP2) {
            PG8_LDB(B0, 0, 0); PG8_LDB(B1, 0, 1); PG8_SCHED; PG8_LDA(At, 0, 0); PG8_STAGE(PG8_SA(1, 1), a1 + hstep, voffA);
            PG8_WAIT_V(8); PG8_WAIT_L(0); PG8_BAR; PG8_MMA(0, 0, At, B0); PG8_MMA(0, 1, At, B1); PG8_BAR; PG8_SCHED;
            PG8_LDA(At, 0, 1); PG8_STAGE(PG8_SB(0, 0), b2, voffB); PG8_STAGE(PG8_SB(0, 1), b2 + hstep, voffB); PG8_STAGE(PG8_SA(0, 0), a2, voffA);
            PG8_WAIT_V(8); PG8_WAIT_L(0); PG8_BAR; PG8_MMA(1, 0, At, B0); PG8_MMA(1, 1, At, B1); PG8_BAR; PG8_SCHED;
            PG8_LDB(B0, 1, 0); PG8_LDB(B1, 1, 1); PG8_SCHED; PG8_LDA(At, 1, 0); PG8_STAGE(PG8_SA(0, 1), a2 + hstep, voffA);
            PG8_WAIT_V(8); PG8_WAIT_L(0); PG8_BAR; PG8_MMA(0, 0, At, B0); PG8_MMA(0, 1, At, B1); PG8_BAR; PG8_SCHED;
            PG8_LDA(At, 1, 1); PG8_STAGE(PG8_SB(1, 0), b3, voffB); PG8_STAGE(PG8_SB(1, 1), b3 + hstep, voffB); PG8_STAGE(PG8_SA(1, 0), a3, voffA);
            PG8_WAIT_V(8); PG8_WAIT_L(0); PG8_BAR; PG8_MMA(1, 0, At, B0); PG8_MMA(1, 1, At, B1); PG8_BAR; PG8_SCHED;
            } else {
            PG8_LDB(B0, 0, 0); PG8_SCHED; PG8_LDA(At, 0, 0); PG8_STAGE(PG8_SA(1, 1), a1 + hstep, voffA);
            PG8_WAIT_L(8); PG8_BAR; PG8_WAIT_L(0); PG8_MMA(0, 0, At, B0); PG8_BAR; PG8_SCHED;
            PG8_LDB(B1, 0, 1); PG8_STAGE(PG8_SB(0, 0), b2, voffB);
            PG8_BAR; PG8_WAIT_L(0); PG8_MMA(0, 1, At, B1); PG8_BAR;
            PG8_LDA(At, 0, 1); PG8_STAGE(PG8_SA(0, 0), a2, voffA);
            PG8_BAR; PG8_WAIT_L(0); PG8_MMA(1, 0, At, B0); PG8_BAR; PG8_SCHED;
            PG8_STAGE(PG8_SB(0, 1), b2 + hstep, voffB);
            PG8_WAIT_V(6); PG8_BAR; PG8_MMA(1, 1, At, B1); PG8_BAR;
            PG8_LDB(B0, 1, 0); PG8_SCHED; PG8_LDA(At, 1, 0); PG8_STAGE(PG8_SA(0, 1), a2 + hstep, voffA);
            PG8_WAIT_L(8); PG8_BAR; PG8_WAIT_L(0); PG8_MMA(0, 0, At, B0); PG8_BAR; PG8_SCHED;
            PG8_LDB(B1, 1, 1); PG8_STAGE(PG8_SB(1, 0), b3, voffB);
            PG8_BAR; PG8_WAIT_L(0); PG8_MMA(0, 1, At, B1); PG8_BAR;
            PG8_LDA(At, 1, 1); PG8_STAGE(PG8_SA(1, 0), a3, voffA);
            PG8_BAR; PG8_WAIT_L(0); PG8_MMA(1, 0, At, B0); PG8_BAR; PG8_SCHED;
            PG8_STAGE(PG8_SB(1, 1), b3 + hstep, voffB);
            PG8_WAIT_V(6); PG8_BAR; PG8_MMA(1, 1, At, B1); PG8_BAR;
            }
        }
        if constexpr (ALIGN_EPI) { if (wr == 0) PG8_BAR; }
        if constexpr (!Epi::AFTER_DRAIN) { E(acc, cur, wr, wc, fr, fq); S.done(cur); }
        if (!has_next) break;
#pragma unroll
        for (int a = 0; a < 2; ++a)
#pragma unroll
            for (int b = 0; b < 2; ++b)
#pragma unroll
                for (int m = 0; m < 4; ++m)
#pragma unroll
                    for (int n = 0; n < 2; ++n) acc[a][b][m][n] = (f32x4){0.f, 0.f, 0.f, 0.f};
        cur = nxt; cA = nA; cB = nB; ++ui;
        if constexpr (ALIGN_EPI) { if (wr == 1) PG8_BAR; }
    }
    PG8_WAIT_V(0);
    if constexpr (!ALIGN_EPI) { if (wr == 0) PG8_BAR; }
    PG8_BAR;
    if constexpr (Epi::AFTER_DRAIN) { E.fused(acc, cur, wr, wc, fr, fq, lds, wid, lane); S.done(cur); }
#undef PG8_SA
#undef PG8_SB
#undef PG8_STAGE
#undef PG8_LDA
#undef PG8_LDB
#undef PG8_MMA
#undef PG8_WAIT_V
#undef PG8_WAIT_L
#undef PG8_BAR
#undef PG8_SCHED
}
}

#define LAS __attribute__((address_space(3)))
typedef float f32x4 __attribute__((ext_vector_type(4)));
typedef unsigned u32x4 __attribute__((ext_vector_type(4)));
typedef unsigned u32x2 __attribute__((ext_vector_type(2)));
typedef float f32x2 __attribute__((ext_vector_type(2)));
constexpr int NWAVES = 8, NTHR = 512;
constexpr size_t WS_WIN0 = 2 * MiB, WS_WOUT0 = 5 * MiB, WS_WIN1 = 7 * MiB, WS_WOUT1 = 12 * MiB + 512 * 1024, WS_WFIN = 14 * MiB + 512 * 1024, WS_WFOUT = 36 * MiB + 512 * 1024;
static_assert(WS_WFOUT + 2 * (size_t)D * FF * 2 <= WS_XC, "weights fit below XC");
constexpr int LDS_BYTES = 147456;

__device__ __forceinline__ float fast_rcp(float x) { return __builtin_amdgcn_rcpf(x); }
__device__ __forceinline__ float silu_fast(float x) { return x * fast_rcp(1.f + __builtin_amdgcn_exp2f(-1.4426950408889634f * x)); }
__device__ __forceinline__ float sigmoid_fast(float x) { return fast_rcp(1.f + __builtin_amdgcn_exp2f(-1.4426950408889634f * x)); }

__device__ __forceinline__ int srccol(int kind, int n0) {
    const int t = n0 >> 8, p = n0 & 255;
    if (kind == 0) return n0;
    if (kind == 1 || (kind == 2 && n0 < 2304)) return t * 256 + 64 * ((p >> 5) & 3) + 32 * (p >> 7);
    if (kind == 2) return 2304 + (p >> 7) * 256 + 128 * (t - 9) + (p & 127);
    return (p >> 7) * FF + 128 * t + (p & 127);
}
__device__ __forceinline__ unsigned pk2(float lo, float hi) { return f2bf(lo) | (f2bf(hi) << 16); }
__device__ __forceinline__ void transpose_item(const float* W, int K, int N, bf16* WT, int kind, LAS float* scr, int item, int lane) {
    const int nblk = N / 32, kb = item / nblk, nb = item % nblk, k0 = 64 * kb, n0 = 32 * nb, s0 = srccol(kind, n0);
#pragma unroll 8
    for (int i = 0; i < 32; ++i) { const int kk = 2 * i + (lane >> 5); scr[kk * 33 + (lane & 31)] = W[(size_t)(k0 + kk) * N + s0 + (lane & 31)]; }
    asm volatile("s_waitcnt lgkmcnt(0)" ::: "memory");
    const int c = lane & 7;
#pragma unroll
    for (int j = 0; j < 4; ++j) { const int n = (lane >> 3) + 8 * j; const LAS float* s = scr + (8 * c) * 33 + n;
        u32x4 o; o.x = pk2(s[0 * 33], s[1 * 33]); o.y = pk2(s[2 * 33], s[3 * 33]); o.z = pk2(s[4 * 33], s[5 * 33]); o.w = pk2(s[6 * 33], s[7 * 33]);
        *(u32x4*)(WT + (size_t)(n0 + n) * K + k0 + 8 * c) = o; }
    asm volatile("s_waitcnt lgkmcnt(0)" ::: "memory");
}
__device__ __forceinline__ void phase_prep(const Ptrs& p, LAS unsigned char* lds, int vcu, int G, int tid, int wave, int lane) {
    {
        LAS float* scr = (LAS float*)(lds + wave * 16384);
        const int gw = vcu * NWAVES + wave, NGW = G * NWAVES;
        constexpr int I0 = 16 * (P0 / 32), I1 = 16 * (D / 32), I2 = 16 * (CIN1 / 32), I3 = I1, I4 = 16 * (2 * FF / 32), I5 = (FF / 64) * (D / 32);
        constexpr int NITEMS = I0 + I1 + I2 + I3 + 2 * I4 + 2 * I5;
        for (int it = gw; it < NITEMS; it += NGW) {
            int r = it;
            if (r < I0) { transpose_item(p.ab_w_in, D, P0, (bf16*)(p.ws + WS_WIN0), 1, scr, r, lane); continue; } r -= I0;
            if (r < I1) { transpose_item(p.ab_w_out, D, D, (bf16*)(p.ws + WS_WOUT0), 0, scr, r, lane); continue; } r -= I1;
            if (r < I2) { transpose_item(p.cd_w_in, D, CIN1, (bf16*)(p.ws + WS_WIN1), 2, scr, r, lane); continue; } r -= I2;
            if (r < I3) { transpose_item(p.cd_w_out, D, D, (bf16*)(p.ws + WS_WOUT1), 0, scr, r, lane); continue; } r -= I3;
            if (r < 2 * I4) { const int l = r / I4; transpose_item(p.ffn_w_in + (size_t)l * D * 2 * FF, D, 2 * FF, (bf16*)(p.ws + WS_WFIN) + (size_t)l * 2 * FF * D, 3, scr, r % I4, lane); continue; } r -= 2 * I4;
            { const int l = r / I5; transpose_item(p.ffn_w_out + (size_t)l * FF * D, FF, D, (bf16*)(p.ws + WS_WFOUT) + (size_t)l * D * FF, 0, scr, r % I5, lane); }
        }
    }
    __syncthreads();
    if (vcu < 48) {
        LAS float* sl = (LAS float*)lds;
        LAS float* part = (LAS float*)(lds + 9 * 1024 * 4);
        for (int e = tid; e < 9 * 1024; e += NTHR) { const int v = e >> 10, k = e & 1023; sl[e] = silu_f(v < 8 ? p.c[v * D + k] : p.c_ctx[k]); }
        __syncthreads();
        const int l = vcu / 24, cb = (vcu % 24) * 256;
        const float* W = p.ada_w + (size_t)l * D * MODW + cb + 4 * lane;
        f32x4 acc[9];
#pragma unroll
        for (int v = 0; v < 9; ++v) acc[v] = (f32x4){0.f, 0.f, 0.f, 0.f};
#pragma unroll 4
        for (int kk = 0; kk < 128; ++kk) { const int k = wave * 128 + kk; const f32x4 w = *(const f32x4*)(W + (size_t)k * MODW);
#pragma unroll
            for (int v = 0; v < 9; ++v) acc[v] += w * sl[v * 1024 + k]; }
#pragma unroll
        for (int v = 0; v < 9; ++v) *(LAS f32x4*)(part + (wave * 9 + v) * 256 + 4 * lane) = acc[v];
        __syncthreads();
        for (int e = tid; e < 9 * 256; e += NTHR) { const int v = e >> 8, c = e & 255; float s = 0.f;
#pragma unroll
            for (int w = 0; w < 8; ++w) s += part[(w * 9 + v) * 256 + c];
            ((float*)(p.ws + WS_MOD))[(size_t)(l * 9 + v) * MODW + cb + c] = s + p.ada_b[l * MODW + cb + c]; }
        __syncthreads();
    } else if (vcu == 48) {
        for (int e = tid; e < 1024; e += NTHR) { const int pos = e / 16, i = e % 16; const double fr = pow(10000.0, -(2.0 * i) / 32.0), ang = (double)pos * fr;
            float* rope = (float*)(p.ws + WS_ROPE); rope[e] = (float)cos(ang); rope[1024 + e] = (float)sin(ang); }
    }
}

struct TileSched {
    int nM, nN, nwg, G, c, mode, extra;
    __device__ __forceinline__ void init(int nM_, int nN_, int G_, int c_, int mode_, int extra_) { nM = nM_; nN = nN_; nwg = nM * nN; G = G_; c = c_; mode = mode_; extra = extra_; }
    __device__ __forceinline__ bool next(int i, pg8::Unit& u) const {
        const long L = (long)i * G + c; if (L >= nwg + extra) return false;
        if (L >= nwg) { const int e = (int)L - nwg; u.pm = (e / 6) * 9; u.pn = 3 + e % 6; return true; }
        int wgid = (int)L; { const int q = nwg / 8, r = nwg % 8, xcd = wgid % 8, off = wgid / 8; wgid = (xcd < r ? xcd * (q + 1) : r * (q + 1) + (xcd - r) * q) + off; }
        const int nig = 8 * nN, gid = wgid / nig, fm = gid * 8, gsz = (nM - fm) < 8 ? (nM - fm) : 8;
        const int lp = fm + ((wgid % nig) % gsz); u.pn = (wgid % nig) / gsz;
        u.pm = mode ? (lp >> 3) * 9 + 1 + (lp & 7) : lp; return true;
    }
    __device__ __forceinline__ void a_ready(const pg8::Unit&) const {}
    __device__ __forceinline__ void done(const pg8::Unit&) const {}
};
struct EpiIn {
    static constexpr bool PERM = false, AFTER_DRAIN = false;
    const Ptrs* p; int layer;
    __device__ __forceinline__ void operator()(const f32x4 (&acc)[2][2][4][2], const pg8::Unit& u, int wr, int wc, int fr, int fq) const {
        const int pn = u.pn, kind = layer == 0 ? (pn < 3 ? 0 : (pn == 3 ? 1 : 2)) : (pn < 3 ? 0 : (pn < 6 ? 1 : (pn < 9 ? 2 : 3)));
        const int pitch = layer == 0 ? P0 : P1, jrow = u.pm % 9; const bool lat = jrow != 0;
        bf16* O = (bf16*)(p->ws + WS_BIG);
        const float* rope = (const float*)(p->ws + WS_ROPE);
        int lrow = wr * 64 + fr; asm volatile("" : "+v"(lrow));
        f32x4 gn[2][2];
#pragma unroll
        for (int bj = 0; bj < 2; ++bj)
#pragma unroll
            for (int n = 0; n < 2; ++n) gn[bj][n] = (layer == 0 && kind < 2) ? *(const f32x4*)((kind == 0 ? p->ab_q_gain : p->ab_k_gain) + bj * 32 + n * 16 + 4 * fq) : (f32x4){1.f, 1.f, 1.f, 1.f};
#pragma unroll
        for (int ai = 0; ai < 2; ++ai)
#pragma unroll
            for (int m = 0; m < 4; ++m) {
                const int rr = ai * 128 + m * 16 + lrow; const size_t r = (size_t)u.pm * 256 + rr;
                f32x4 a[2][2];
#pragma unroll
                for (int bj = 0; bj < 2; ++bj)
#pragma unroll
                    for (int n = 0; n < 2; ++n) a[bj][n] = acc[ai][bj][m][n];
                if (kind < 2) {
                    if (layer == 0) {
                        float ss = 0.f;
#pragma unroll
                        for (int bj = 0; bj < 2; ++bj)
#pragma unroll
                            for (int n = 0; n < 2; ++n) { const f32x4 x = a[bj][n]; ss += (x[0] * x[0] + x[1] * x[1]) + (x[2] * x[2] + x[3] * x[3]); }
                        ss += __shfl_xor(ss, 16); ss += __shfl_xor(ss, 32);
                        const float rs = 1.f / sqrtf(ss * (1.f / 64.f) + LN_EPS);
#pragma unroll
                        for (int bj = 0; bj < 2; ++bj)
#pragma unroll
                            for (int n = 0; n < 2; ++n) a[bj][n] = a[bj][n] * rs * gn[bj][n];
                    }
                    if (lat) {
                        const int t = (jrow - 1) * 256 + rr, prow = t >> 6, pcol = t & 63;
#pragma unroll
                        for (int bj = 0; bj < 2; ++bj) { const int pos = bj ? pcol : prow;
                            const f32x4 c4 = *(const f32x4*)(rope + pos * 16 + 4 * fq), s4 = *(const f32x4*)(rope + 1024 + pos * 16 + 4 * fq);
                            const f32x4 x1 = a[bj][0], x2 = a[bj][1]; a[bj][0] = x1 * c4 - x2 * s4; a[bj][1] = x2 * c4 + x1 * s4; }
                    }
                    if (kind == 0) {
#pragma unroll
                        for (int bj = 0; bj < 2; ++bj)
#pragma unroll
                            for (int n = 0; n < 2; ++n) a[bj][n] = a[bj][n] * QSCALE; }
                }
                if (kind < 3) {
                    bf16* o = O + r * pitch + pn * 256 + wc * 64 + 4 * fq;
#pragma unroll
                    for (int bj = 0; bj < 2; ++bj)
#pragma unroll
                        for (int n = 0; n < 2; ++n) { const f32x4 x = a[bj][n]; u32x2 w; w.x = pg8::cvt_pk_bf16(x[0], x[1]); w.y = pg8::cvt_pk_bf16(x[2], x[3]); *(u32x2*)(o + bj * 32 + n * 16) = w; }
                } else {
                    bf16* o = O + r * P1 + 2304 + (pn - 9) * 128 + wc * 32 + 4 * fq;
#pragma unroll
                    for (int n = 0; n < 2; ++n) { const f32x4 x = a[0][n], g = a[1][n]; u32x2 w;
                        w.x = pg8::cvt_pk_bf16(x[0] * sigmoid_fast(g[0]), x[1] * sigmoid_fast(g[1])); w.y = pg8::cvt_pk_bf16(x[2] * sigmoid_fast(g[2]), x[3] * sigmoid_fast(g[3])); *(u32x2*)(o + n * 16) = w; }
                }
            }
    }
};
struct EpiRes {
    static constexpr bool PERM = false, AFTER_DRAIN = false;
    const Ptrs* p; int layer, gate_off, in_is_input;
    __device__ __forceinline__ void operator()(const f32x4 (&acc)[2][2][4][2], const pg8::Unit& u, int wr, int wc, int fr, int fq) const {
        const int b = u.pm / 9, j = u.pm % 9; const bool isctx = j == 0;
        const float* gate = (const float*)(p->ws + WS_MOD) + (size_t)(layer * 9 + (isctx ? 8 : b)) * MODW + gate_off;
        float* resbase = isctx ? (float*)(p->ws + WS_XC) + (size_t)(b * CTXL) * D : p->out + (size_t)(b * SEQ + (j - 1) * 256) * D;
        const float* inbase = in_is_input ? (isctx ? p->ctx + (size_t)(b * CTXL) * D : p->x + (size_t)(b * SEQ + (j - 1) * 256) * D) : resbase;
        const int col0 = u.pn * 256 + wc * 32 + 4 * fq;
        int lrow = wr * 64 + fr; asm volatile("" : "+v"(lrow));
        f32x4 gv[2][2];
#pragma unroll
        for (int bj = 0; bj < 2; ++bj)
#pragma unroll
            for (int n = 0; n < 2; ++n) gv[bj][n] = *(const f32x4*)(gate + col0 + bj * 128 + n * 16);
#pragma unroll
        for (int ai = 0; ai < 2; ++ai)
#pragma unroll
            for (int m = 0; m < 4; ++m) { const size_t off = (size_t)(ai * 128 + m * 16 + lrow) * D + col0;
#pragma unroll
                for (int bj = 0; bj < 2; ++bj)
#pragma unroll
                    for (int n = 0; n < 2; ++n) { const f32x4 xin = *(const f32x4*)(inbase + off + bj * 128 + n * 16);
                        *(f32x4*)(resbase + off + bj * 128 + n * 16) = xin * ALPHA + gv[bj][n] * acc[ai][bj][m][n]; } }
    }
};
struct EpiFfn {
    static constexpr bool PERM = true, AFTER_DRAIN = false;
    bf16* O;
    __device__ __forceinline__ void operator()(const f32x4 (&acc)[2][2][4][2], const pg8::Unit& u, int wr, int wc, int fr, int fq) const {
        const int h0 = u.pn * 128 + wc * 32 + 8 * fq;
        int lrow = wr * 64 + fr; asm volatile("" : "+v"(lrow));
#pragma unroll
        for (int ai = 0; ai < 2; ++ai)
#pragma unroll
            for (int m = 0; m < 4; ++m) { const size_t r = (size_t)u.pm * 256 + ai * 128 + m * 16 + lrow;
                const f32x4 a0 = acc[ai][0][m][0], a1 = acc[ai][0][m][1], g0 = acc[ai][1][m][0], g1 = acc[ai][1][m][1]; u32x4 w;
                w.x = pg8::cvt_pk_bf16(silu_fast(g0[0]) * a0[0], silu_fast(g0[1]) * a0[1]); w.y = pg8::cvt_pk_bf16(silu_fast(g0[2]) * a0[2], silu_fast(g0[3]) * a0[3]);
                w.z = pg8::cvt_pk_bf16(silu_fast(g1[0]) * a1[0], silu_fast(g1[1]) * a1[1]); w.w = pg8::cvt_pk_bf16(silu_fast(g1[2]) * a1[2], silu_fast(g1[3]) * a1[3]);
                *(u32x4*)(O + r * FF + h0) = w; }
    }
};
namespace att {
typedef short bf16x8 __attribute__((ext_vector_type(8)));
typedef short s16x4 __attribute__((ext_vector_type(4)));
typedef float f32x16 __attribute__((ext_vector_type(16)));
#define SBAR() __builtin_amdgcn_sched_barrier(0)
constexpr float THR = 8.f;
__device__ __forceinline__ int crow(int r, int hi) { return (r & 3) + 8 * (r >> 2) + 4 * hi; }
__device__ __forceinline__ unsigned cvtpk(float lo, float hi) { unsigned r; asm volatile("v_cvt_pk_bf16_f32 %0, %1, %2" : "=v"(r) : "v"(lo), "v"(hi)); return r; }
__device__ __forceinline__ void partialSM(f32x16& p0, f32x16& p1, float& m_reg, float& mn, float& alpha) {
    float pmax = p0[0];
#pragma unroll
    for (int r = 1; r < 16; ++r) pmax = fmaxf(pmax, p0[r]);
#pragma unroll
    for (int r = 0; r < 16; ++r) pmax = fmaxf(pmax, p1[r]);
    { auto rr = __builtin_amdgcn_permlane32_swap(__float_as_uint(pmax), __float_as_uint(pmax), false, false); pmax = fmaxf(__uint_as_float(rr[0]), __uint_as_float(rr[1])); }
    if (__builtin_expect(__all(pmax - m_reg <= THR), 1)) { mn = m_reg; alpha = 1.f; }
    else { mn = fmaxf(m_reg, pmax); alpha = __builtin_amdgcn_exp2f(m_reg - mn); m_reg = mn; }
#pragma unroll
    for (int r = 0; r < 16; ++r) { p0[r] -= mn; p1[r] -= mn; }
#pragma unroll
    for (int r = 0; r < 16; ++r) p0[r] = __builtin_amdgcn_exp2f(p0[r]);
}
__device__ __forceinline__ void finishSM(f32x16& p0, f32x16& p1, float alpha, float& l_reg, bf16x8& pa0, bf16x8& pa1, bf16x8& pa2, bf16x8& pa3) {
#pragma unroll
    for (int r = 0; r < 16; ++r) p1[r] = __builtin_amdgcn_exp2f(p1[r]);
    float ps = 0;
#pragma unroll
    for (int r = 0; r < 16; ++r) ps += p0[r];
#pragma unroll
    for (int r = 0; r < 16; ++r) ps += p1[r];
    { auto rr = __builtin_amdgcn_permlane32_swap(__float_as_uint(ps), __float_as_uint(ps), false, false); ps = __uint_as_float(rr[0]) + __uint_as_float(rr[1]); }
    l_reg = l_reg * alpha + ps;
#define PK4(P, BASE, OUT) do { unsigned a0 = cvtpk(P[BASE + 0], P[BASE + 1]), a1 = cvtpk(P[BASE + 2], P[BASE + 3]);   \
    unsigned b0 = cvtpk(P[BASE + 4], P[BASE + 5]), b1 = cvtpk(P[BASE + 6], P[BASE + 7]);                              \
    auto r0 = __builtin_amdgcn_permlane32_swap(a0, b0, false, false); auto r1 = __builtin_amdgcn_permlane32_swap(a1, b1, false, false); \
    u32x4 w = {r0[0], r1[0], r0[1], r1[1]}; OUT = __builtin_bit_cast(bf16x8, w); } while (0)
    PK4(p0, 0, pa0); PK4(p0, 8, pa1); PK4(p1, 0, pa2); PK4(p1, 8, pa3);
#undef PK4
}
__device__ __forceinline__ int kswz(int row, int colB) { return row * 128 + (colB ^ (((row >> 1) & 7) << 4)); }
__device__ __forceinline__ void qkt(f32x16& p0, f32x16& p1, LAS const unsigned char* Ks, const bf16x8 (&qr)[4], int r32, int hi) {
    p0 = f32x16{}; p1 = f32x16{};
#pragma unroll
    for (int d0 = 0; d0 < 4; ++d0) { const int cb = d0 * 32 + hi * 16;
        const bf16x8 b0 = *(LAS const bf16x8*)(Ks + kswz(r32, cb));
        const bf16x8 b1 = *(LAS const bf16x8*)(Ks + kswz(32 + r32, cb));
        p0 = __builtin_amdgcn_mfma_f32_32x32x16_bf16(b0, qr[d0], p0, 0, 0, 0);
        p1 = __builtin_amdgcn_mfma_f32_32x32x16_bf16(b1, qr[d0], p1, 0, 0, 0); }
}
template <int DV> __device__ __forceinline__ int v_st(int k, int c) { const int kk = (k & ~0xC) | ((k & 4) << 1) | ((k & 8) >> 1); return ((kk >> 3) * (DV / 32) + (c >> 5)) * 512 + ((kk & 7) * 32 + (c & 31)) * 2; }
__device__ __forceinline__ int v_rd_base(int lane) { return ((lane & 3) << 3) | (((lane >> 2) & 3) << 6) | (((lane >> 4) & 1) << 5) | (((lane >> 5) & 1) << 8); }
template <int DV> constexpr int v_rd_off(int d0, int ks, int half) { return d0 * 512 + ks * (2 * (DV / 32) * 512) + half * ((DV / 32) * 512); }
template <int OFF> __device__ __forceinline__ s16x4 tr_read(int vb) { s16x4 r; asm volatile("ds_read_b64_tr_b16 %0, %1 offset:%2" : "=&v"(r) : "v"(vb), "i"(OFF) : "memory"); return r; }
template <int DV, int D0> __device__ __forceinline__ void pv_one(f32x16& od, int vb, bf16x8 pa0, bf16x8 pa1, bf16x8 pa2, bf16x8 pa3) {
    const s16x4 l0 = tr_read<v_rd_off<DV>(D0, 0, 0)>(vb), h0 = tr_read<v_rd_off<DV>(D0, 0, 1)>(vb), l1 = tr_read<v_rd_off<DV>(D0, 1, 0)>(vb), h1 = tr_read<v_rd_off<DV>(D0, 1, 1)>(vb);
    const s16x4 l2 = tr_read<v_rd_off<DV>(D0, 2, 0)>(vb), h2 = tr_read<v_rd_off<DV>(D0, 2, 1)>(vb), l3 = tr_read<v_rd_off<DV>(D0, 3, 0)>(vb), h3 = tr_read<v_rd_off<DV>(D0, 3, 1)>(vb);
    asm volatile("s_waitcnt lgkmcnt(0)" ::: "memory"); SBAR();
#define PK(L, H) (bf16x8){L[0], L[1], L[2], L[3], H[0], H[1], H[2], H[3]}
    od = __builtin_amdgcn_mfma_f32_32x32x16_bf16(pa0, PK(l0, h0), od, 0, 0, 0);
    od = __builtin_amdgcn_mfma_f32_32x32x16_bf16(pa1, PK(l1, h1), od, 0, 0, 0);
    od = __builtin_amdgcn_mfma_f32_32x32x16_bf16(pa2, PK(l2, h2), od, 0, 0, 0);
    od = __builtin_amdgcn_mfma_f32_32x32x16_bf16(pa3, PK(l3, h3), od, 0, 0, 0);
#undef PK
}
template <int DV> __device__ __forceinline__ void pv_all(f32x16 (&o)[DV / 32], int vb, bf16x8 pa0, bf16x8 pa1, bf16x8 pa2, bf16x8 pa3) {
    pv_one<DV, 0>(o[0], vb, pa0, pa1, pa2, pa3); pv_one<DV, 1>(o[1], vb, pa0, pa1, pa2, pa3);
    if constexpr (DV == 128) { pv_one<DV, 2>(o[2], vb, pa0, pa1, pa2, pa3); pv_one<DV, 3>(o[3], vb, pa0, pa1, pa2, pa3); }
}
template <int NKT, int DV> struct Cfg { static constexpr int KB = 8192, VB = 64 * DV * 2, BUF = NKT * KB + VB, SCR = 2 * BUF, TOTAL = SCR + NWAVES * 256; };
template <int NKT, int DV>
__device__ __forceinline__ void attn_unit(const bf16* Qw, const bf16* const (&Kg)[NKT], const bf16* Vg, int ld, int NT, int kidx, LAS unsigned char* lds, f32x16 (&o)[DV / 32], float& l_out) {
    typedef Cfg<NKT, DV> C;
    const int tid = otid(), wid = tid >> 6, lane = tid & 63, r32 = lane & 31, hi = lane >> 5;
    LAS float* al_l = (LAS float*)(lds + C::SCR) + wid * 64;
    float m_reg = -1e30f, l_reg = 0.f;
#pragma unroll
    for (int d = 0; d < DV / 32; ++d) o[d] = f32x16{};
    bf16x8 qr[4];
#pragma unroll
    for (int d0 = 0; d0 < 4; ++d0) qr[d0] = *(const bf16x8*)(Qw + d0 * 16);
    const int krow = tid >> 3, kch = tid & 7, kst = kswz(krow, kch * 16);
    const int vrow = DV == 64 ? (tid >> 3) : (tid >> 4), vcol = DV == 64 ? (tid & 7) * 8 : (tid & 15) * 8;
    const int vst0 = v_st<DV>(vrow, vcol), vst1 = v_st<DV>(32 + vrow, vcol);
    const int vb0 = (int)(uintptr_t)(lds + NKT * C::KB) + v_rd_base(lane);
    struct { bf16x8 k[NKT]; bf16x8 v[DV / 64]; } sr_[2];
#define SLOAD(i, k0) do { _Pragma("unroll") for (int kt = 0; kt < NKT; ++kt) sr_[i].k[kt] = *(const bf16x8*)(Kg[kt] + (size_t)((k0) + krow) * ld + kch * 8); \
        sr_[i].v[0] = *(const bf16x8*)(Vg + (size_t)((k0) + vrow) * ld + vcol); if constexpr (DV == 128) sr_[i].v[1] = *(const bf16x8*)(Vg + (size_t)((k0) + 32 + vrow) * ld + vcol); } while (0)
#define SWRITE(b, i) do { _Pragma("unroll") for (int kt = 0; kt < NKT; ++kt) *(LAS bf16x8*)(lds + (b) * C::BUF + kt * C::KB + kst) = sr_[i].k[kt]; \
        *(LAS bf16x8*)(lds + (b) * C::BUF + NKT * C::KB + vst0) = sr_[i].v[0]; if constexpr (DV == 128) *(LAS bf16x8*)(lds + (b) * C::BUF + NKT * C::KB + vst1) = sr_[i].v[1]; } while (0)
#define SWAIT() do { if constexpr (NKT + DV / 64 == 2) asm volatile("s_waitcnt vmcnt(2)" ::: "memory"); else asm volatile("s_waitcnt vmcnt(4)" ::: "memory"); } while (0)
#define RESC(a) do { if (__any((a) < 1.f)) { if (hi == 0) al_l[r32] = (a); asm volatile("s_waitcnt lgkmcnt(0)" ::: "memory"); \
        _Pragma("unroll") for (int d = 0; d < DV / 32; ++d) _Pragma("unroll") for (int r = 0; r < 16; ++r) o[d][r] *= al_l[crow(r, hi)]; } } while (0)
    f32x16 pA0, pA1, pB0, pB1; float mnA, mnB, alA, alB; bf16x8 pa0, pa1, pa2, pa3;
    LAS const unsigned char* K0 = lds + kidx * C::KB; LAS const unsigned char* K1 = lds + C::BUF + kidx * C::KB;
    SLOAD(0, 0); asm volatile("s_waitcnt vmcnt(0)" ::: "memory"); SWRITE(0, 0); __syncthreads();
    qkt(pA0, pA1, K0, qr, r32, hi); partialSM(pA0, pA1, m_reg, mnA, alA);
    SLOAD(1, 64); if (2 < NT) SLOAD(0, 128);
    SWAIT(); SWRITE(1, 1); __syncthreads();
    for (int j = 1; j + 1 < NT; j += 2) {
        SBAR(); qkt(pB0, pB1, K1, qr, r32, hi);
        finishSM(pA0, pA1, alA, l_reg, pa0, pa1, pa2, pa3); SBAR();
        SLOAD(1, (j + 2) * 64); SBAR();
        pv_all<DV>(o, vb0, pa0, pa1, pa2, pa3); partialSM(pB0, pB1, m_reg, mnB, alB);
        __syncthreads(); SWAIT(); SWRITE(0, 0);
        RESC(alB); __syncthreads();
        SBAR(); qkt(pA0, pA1, K0, qr, r32, hi);
        finishSM(pB0, pB1, alB, l_reg, pa0, pa1, pa2, pa3); SBAR();
        if (j + 3 < NT) SLOAD(0, (j + 3) * 64); SBAR();
        pv_all<DV>(o, vb0 + C::BUF, pa0, pa1, pa2, pa3); partialSM(pA0, pA1, m_reg, mnA, alA);
        __syncthreads(); SWAIT(); SWRITE(1, 1);
        RESC(alA); __syncthreads();
    }
    SBAR(); qkt(pB0, pB1, K1, qr, r32, hi);
    finishSM(pA0, pA1, alA, l_reg, pa0, pa1, pa2, pa3); SBAR();
    pv_all<DV>(o, vb0, pa0, pa1, pa2, pa3); partialSM(pB0, pB1, m_reg, mnB, alB);
    __syncthreads(); RESC(alB);
    finishSM(pB0, pB1, alB, l_reg, pa0, pa1, pa2, pa3); SBAR();
    pv_all<DV>(o, vb0 + C::BUF, pa0, pa1, pa2, pa3);
    l_out = l_reg;
#undef SLOAD
#undef SWRITE
#undef SWAIT
#undef RESC
}
#undef SBAR
}

__device__ __forceinline__ void attn0_unit(const Ptrs& p, LAS unsigned char* lds, int b, int h, int qb  ) {
    const int tid = otid(), wid = tid >> 6, lane = tid & 63, r32 = lane & 31, hi = lane >> 5, kvh = h / 3;
    const bf16* QKV = (const bf16*)(p.ws + WS_BIG);
    const size_t row0 = (size_t)b * TOK + qb * 256 + wid * 32;
    const bf16* Qw = QKV + (row0 + r32) * P0 + h * 64 + hi * 8;
    const bf16* const Kg[1] = {QKV + (size_t)b * TOK * P0 + 768 + kvh * 64};
    const bf16* Vg = QKV + (size_t)b * TOK * P0 + 1024 + kvh * 64;
    att::f32x16 o[2]; float l;
    att::attn_unit<1, 64>(Qw, Kg, Vg, P0, qb == 0 ? CTXL / 64 : TOK / 64, 0, lds, o, l);
    LAS float* li_l = (LAS float*)(lds + att::Cfg<1, 64>::SCR) + wid * 64;
    if (hi == 0) li_l[r32] = l; asm volatile("s_waitcnt lgkmcnt(0)" ::: "memory");
    int lofs = hi * 4 * D + r32; asm volatile("" : "+v"(lofs));
    bf16* Ob = (bf16*)(p.ws + WS_BUFB) + row0 * D + h * 64 + lofs;
#pragma unroll
    for (int r = 0; r < 16; ++r) { const float il = fast_rcp(li_l[att::crow(r, hi)]);
#pragma unroll
        for (int d0 = 0; d0 < 2; ++d0) Ob[((r & 3) + 8 * (r >> 2)) * D + d0 * 32] = (bf16)f2bf(o[d0][r] * il); }
    __syncthreads();
}
__device__ __forceinline__ void pool_chunk(const Ptrs& p, LAS unsigned char* lds, int chunk) {
    const int tid = otid();
    int rbase, n, t0;
    if (chunk < 256) { const int b = chunk / 32; rbase = b * TOK + CTXL; n = SEQ; t0 = (chunk % 32) * 64; }
    else { const int e = chunk - 256, b = e / 4; rbase = b * TOK; n = CTXL; t0 = (e % 4) * 64; }
    const bf16* U = (const bf16*)(p.ws + WS_BIG) + 1280;
    LAS unsigned short* ub = (LAS unsigned short*)lds;
    LAS float* pooled = (LAS float*)(lds + 80 * 512);
    for (int idx = tid; idx < 80 * 32; idx += NTHR) { const int row = idx >> 5, ch = (idx & 31) * 8, s = t0 - 8 + row;
        u32x4 v = {0u, 0u, 0u, 0u}; if (s >= 0 && s < n) v = *(const u32x4*)(U + (size_t)(rbase + s) * P0 + ch);
        *(LAS u32x4*)(ub + row * 256 + ch) = v; }
    __syncthreads();
    { const int c = tid & 255, g = c >> 6, w = 2 << g, half = tid >> 8;
        for (int tt = half * 32; tt < half * 32 + 32; ++tt) { const int t = t0 + tt, lo = max(t - w / 2, 0), hi = min(t + w - w / 2, n); float s = 0.f;
            for (int j = lo; j < hi; ++j) s += bf2f(ub[(j - t0 + 8) * 256 + c]);
            pooled[tt * 260 + c] = s / (float)(hi - lo) - bf2f(ub[(tt + 8) * 256 + c]); } }
    __syncthreads();
    { const int tb = tid >> 5, db = tid & 31, g = db >> 3, d0 = (db & 7) * 8; const float* W = p.ab_w_pool + (size_t)g * 4096 + d0;
        float acc[4][8];
#pragma unroll
        for (int i = 0; i < 4; ++i)
#pragma unroll
            for (int j = 0; j < 8; ++j) acc[i][j] = 0.f;
#pragma unroll 4
        for (int c = 0; c < 64; ++c) { const f32x4 w0 = *(const f32x4*)(W + c * 64), w1 = *(const f32x4*)(W + c * 64 + 4);
#pragma unroll
            for (int i = 0; i < 4; ++i) { const float pv = pooled[(tb * 4 + i) * 260 + g * 64 + c];
#pragma unroll
                for (int j = 0; j < 4; ++j) { acc[i][j] += pv * w0[j]; acc[i][4 + j] += pv * w1[j]; } } }
        const f32x4 s0 = *(const f32x4*)(p.ab_pool_scale + g * 64 + d0), s1 = *(const f32x4*)(p.ab_pool_scale + g * 64 + d0 + 4);
#pragma unroll
        for (int i = 0; i < 4; ++i) { u32x4 o; o.x = pk2(acc[i][0] * s0[0], acc[i][1] * s0[1]); o.y = pk2(acc[i][2] * s0[2], acc[i][3] * s0[3]); o.z = pk2(acc[i][4] * s1[0], acc[i][5] * s1[1]); o.w = pk2(acc[i][6] * s1[2], acc[i][7] * s1[3]);
            *(u32x4*)((bf16*)(p.ws + WS_BUFB) + (size_t)(rbase + t0 + tb * 4 + i) * D + 768 + g * 64 + d0) = o; } }
    __syncthreads();
}
__device__ __forceinline__ void phase_mix0(const Ptrs& p, LAS unsigned char* lds, int vcu) {
    const int x = vcu >> 5, c = vcu & 31;
    for (int i = 0; i < 3; ++i) { const int uidx = i * 32 + c, pair = x * 4 + uidx / 24, w = uidx % 24; attn0_unit(p, lds, pair >> 2, (pair & 3) * 3 + w / 8, 1 + (w & 7)); }
    if (vcu < 96) attn0_unit(p, lds, vcu / 12, vcu % 12, 0);
    for (int ch = vcu; ch < 288; ch += 256) pool_chunk(p, lds, ch);
}

__device__ __forceinline__ void attn1_unit(const Ptrs& p, LAS unsigned char* lds, int b, int h, int qb  , float lam) {
    typedef att::Cfg<2, 128> C;
    const int tid = otid(), wid = tid >> 6, lane = tid & 63, r32 = lane & 31, hi = lane >> 5, comp = wid >> 2, wq = wid & 3;
    const bf16* QKV = (const bf16*)(p.ws + WS_BIG);
    const size_t row0 = (size_t)b * TOK + CTXL + qb * 128 + wq * 32;
    const bf16* Qw = QKV + (row0 + r32) * P1 + (h * 2 + comp) * 64 + hi * 8;
    const bf16* const Kg[2] = {QKV + (size_t)b * TOK * P1 + 768 + (h * 2) * 64, QKV + (size_t)b * TOK * P1 + 768 + (h * 2 + 1) * 64};
    const bf16* Vg = QKV + (size_t)b * TOK * P1 + 1536 + h * 128;
    att::f32x16 o[4]; float l;
    att::attn_unit<2, 128>(Qw, Kg, Vg, P1, TOK / 64, comp, lds, o, l);
    LAS float* li_l = (LAS float*)(lds + C::SCR) + wid * 64;
    if (hi == 0) li_l[r32] = l; asm volatile("s_waitcnt lgkmcnt(0)" ::: "memory");
    LAS float* X = (LAS float*)(lds + C::TOTAL) + wq * 4096;
#pragma unroll
    for (int r = 0; r < 16; ++r) { const float il = fast_rcp(li_l[att::crow(r, hi)]);
#pragma unroll
        for (int d0 = 0; d0 < 4; ++d0) o[d0][r] *= il; }
    if (comp == 1) {
#pragma unroll
        for (int d0 = 0; d0 < 4; ++d0)
#pragma unroll
            for (int r = 0; r < 16; ++r) X[(d0 * 16 + r) * 64 + lane] = o[d0][r];
    }
    __syncthreads();
    if (comp == 0) {
        int lofs = hi * 4 * D + r32; asm volatile("" : "+v"(lofs));
        bf16* Ob = (bf16*)(p.ws + WS_BUFB) + row0 * D + h * 128 + lofs;
        float gsub[4];
#pragma unroll
        for (int d0 = 0; d0 < 4; ++d0) gsub[d0] = p.subln[d0 * 32 + r32];
#pragma unroll
        for (int r = 0; r < 16; ++r) { float ss = 0.f;
#pragma unroll
            for (int d0 = 0; d0 < 4; ++d0) { o[d0][r] -= lam * X[(d0 * 16 + r) * 64 + lane]; ss += o[d0][r] * o[d0][r]; }
            ss += __shfl_xor(ss, 1); ss += __shfl_xor(ss, 2); ss += __shfl_xor(ss, 4); ss += __shfl_xor(ss, 8); ss += __shfl_xor(ss, 16);
            const float rs = (1.f - LAM_INIT) / sqrtf(ss * (1.f / 128.f) + LN_EPS);
#pragma unroll
            for (int d0 = 0; d0 < 4; ++d0) Ob[((r & 3) + 8 * (r >> 2)) * D + d0 * 32] = (bf16)f2bf(o[d0][r] * rs * gsub[d0]); }
    }
    __syncthreads();
}
__device__ __forceinline__ void conv_chunk(const Ptrs& p, LAS unsigned char* lds, int chunk) {
    const int tid = otid(), wave = tid >> 6, lane = tid & 63, b = chunk / 32, t0 = (chunk % 32) * 64;
    const bf16* Z = (const bf16*)(p.ws + WS_BIG) + (size_t)(b * TOK + CTXL) * P1 + 2304;
    LAS unsigned* zb = (LAS unsigned*)lds;
    LAS float* cv = (LAS float*)(lds + 94 * 512);
    for (int idx = tid; idx < 94 * 32; idx += NTHR) { const int row = idx >> 5, ch = (idx & 31) * 8, s = t0 - 15 + row;
        u32x4 v = {0u, 0u, 0u, 0u}; if (s >= 0 && s < SEQ) v = *(const u32x4*)(Z + (size_t)s * P1 + ch);
        *(LAS u32x4*)((LAS unsigned short*)zb + row * 256 + ch) = v; }
    __syncthreads();
    { const int cp = tid & 127, tg = tid >> 7;
        unsigned zw[46];
#pragma unroll
        for (int i = 0; i < 46; ++i) zw[i] = zb[(tg * 16 + i) * 128 + cp];
        float a0[16], a1[16]; const float b0 = p.conv_b[2 * cp], b1 = p.conv_b[2 * cp + 1];
#pragma unroll
        for (int i = 0; i < 16; ++i) { a0[i] = b0; a1[i] = b1; }
#pragma unroll
        for (int j = 0; j < 31; ++j) { const f32x2 w = *(const f32x2*)(p.conv_w + j * 256 + 2 * cp);
#pragma unroll
            for (int i = 0; i < 16; ++i) { const unsigned z = zw[i + j]; a0[i] += __builtin_bit_cast(float, z << 16) * w.x; a1[i] += __builtin_bit_cast(float, z & 0xffff0000u) * w.y; } }
#pragma unroll
        for (int i = 0; i < 16; ++i) *(LAS f32x2*)(cv + (tg * 16 + i) * 256 + 2 * cp) = (f32x2){a0[i], a1[i]}; }
    __syncthreads();
    { const f32x4 g = *(const f32x4*)(p.conv_ln_g + 4 * lane), bb = *(const f32x4*)(p.conv_ln_b + 4 * lane);
        for (int i = 0; i < 8; ++i) { const int tt = wave * 8 + i; f32x4 v = *(LAS f32x4*)(cv + tt * 256 + 4 * lane);
            const float mean = wave_sum((v[0] + v[1]) + (v[2] + v[3])) * (1.f / 256.f); v = v - mean;
            const float rstd = 1.f / sqrtf(wave_sum((v[0] * v[0] + v[1] * v[1]) + (v[2] * v[2] + v[3] * v[3])) * (1.f / 256.f) + LN_EPS);
            v = v * rstd * g + bb; u32x2 o; o.x = pk2(silu_fast(v[0]), silu_fast(v[1])); o.y = pk2(silu_fast(v[2]), silu_fast(v[3]));
            *(u32x2*)((bf16*)(p.ws + WS_BUFB) + (size_t)(b * TOK + CTXL + t0 + tt) * D + 768 + 4 * lane) = o; } }
    __syncthreads();
}
__device__ __forceinline__ void phase_mix1(const Ptrs& p, LAS unsigned char* lds, int vcu) {
    LAS float* lamp = (LAS float*)(lds + LDS_BYTES - 64);
    if (otid() < 64) { const int l = otid(); const float a = wave_sum(p.lq1[l] * p.lk1[l]), c = wave_sum(p.lq2[l] * p.lk2[l]); if (l == 0) lamp[0] = expf(a) - expf(c) + LAM_INIT; }
    __syncthreads();
    const float lam = lamp[0];
    const int x = vcu >> 5, c = vcu & 31;
    for (int i = 0; i < 3; ++i) { const int uidx = i * 32 + c, grp = x * 6 + uidx / 16; attn1_unit(p, lds, grp / 6, grp % 6, uidx & 15, lam); }
    conv_chunk(p, lds, vcu);
}
#define XB_TMO      128
#define XB_XCNT(j)  (256  + 64 * (j))
#define XB_XSUB(j)  (1280 + 64 * (j))
#define XB_XGEN(j)  (2304 + 64 * (j))
#define XB_TOP      3328
#define XB_TOPGEN   3392
#define XCD_BAR_WORDS 3456
#define XB_SPIN_CAP (1u << 18)

__device__ __forceinline__ unsigned xb_ld(unsigned* p)              { return __hip_atomic_load(p, __ATOMIC_RELAXED, __HIP_MEMORY_SCOPE_AGENT); }
__device__ __forceinline__ unsigned xb_add(unsigned* p, unsigned v) { return __hip_atomic_fetch_add(p, v, __ATOMIC_RELAXED, __HIP_MEMORY_SCOPE_AGENT); }
__device__ __forceinline__ unsigned xb_xcc_id() { return (unsigned)__builtin_amdgcn_s_getreg((3 << 11) | 20) & 0xFu; }
#define XB_SPIN(cond, bar) do { unsigned _sp = 0; while (cond) { __builtin_amdgcn_s_sleep(1); \
    if ((++_sp & 255u) == 0u) { if (xb_ld(&(bar)[XB_TMO])) break; if (_sp > XB_SPIN_CAP) { atomicAdd(&(bar)[XB_TMO], 1u); break; } } } } while (0)

struct XcdBarrier {
    unsigned* bar; unsigned x;
    volatile LAS unsigned* st;
};

__device__ __forceinline__ XcdBarrier xcd_barrier_post(unsigned* bar, volatile LAS unsigned* st) {
    XcdBarrier b; b.bar = bar; b.x = xb_xcc_id(); b.st = st;
    if (otid() == 0) (void)xb_add(&bar[XB_XCNT(b.x)], 1u);
    return b;
}
__device__ __forceinline__ void xcd_barrier_complete(unsigned* bar, unsigned x, unsigned& nloc, unsigned& nx) {
    const unsigned G = gridDim.x * gridDim.y * gridDim.z;
    unsigned sum, cnt, mine, sp = 0u;
    for (;;) {
        sum = 0u; cnt = 0u; mine = 0u;
#pragma unroll
        for (unsigned j = 0; j < 16; ++j) { const unsigned c = xb_ld(&bar[XB_XCNT(j)]); sum += c; cnt += (c > 0u) ? 1u : 0u; mine = (j == x) ? c : mine; }
        if (sum == G) break;
        __builtin_amdgcn_s_sleep(1);
        if ((++sp & 255u) == 0u) { if (xb_ld(&bar[XB_TMO])) break; if (sp > XB_SPIN_CAP) { atomicAdd(&bar[XB_TMO], 1u); break; } }
    }
    nloc = mine > 0u ? mine : 1u; nx = cnt > 0u ? cnt : 1u;
}

__device__ __forceinline__ void xcd_barrier(const XcdBarrier& b) {
    asm volatile("s_waitcnt vmcnt(0)" ::: "memory");
    __syncthreads();
    if (otid() == 0) {
        unsigned* bar = b.bar;
        __builtin_amdgcn_s_waitcnt(0);
        unsigned nloc = b.st[0], nx = b.st[1];
        if (nloc == 0u) { xcd_barrier_complete(bar, b.x, nloc, nx); b.st[0] = nloc; b.st[1] = nx; }
        const unsigned old = xb_add(&bar[XB_XSUB(b.x)], 1u);
        const unsigned gen = old / nloc;
        if (old + 1u == (gen + 1u) * nloc) {
            __builtin_amdgcn_fence(__ATOMIC_RELEASE, "agent");
            asm volatile("s_waitcnt vmcnt(0)" ::: "memory");
            const unsigned og = xb_add(&bar[XB_TOP], 1u);
            const unsigned tg = og / nx;
            if (og + 1u == (tg + 1u) * nx) xb_add(&bar[XB_TOPGEN], 1u);
            else XB_SPIN(xb_ld(&bar[XB_TOPGEN]) == tg, bar);
            __builtin_amdgcn_fence(__ATOMIC_ACQUIRE, "agent");
            xb_add(&bar[XB_XGEN(b.x)], 1u);
            asm volatile("s_waitcnt vmcnt(0)" ::: "memory");
        } else {
            XB_SPIN(xb_ld(&bar[XB_XGEN(b.x)]) == gen, bar);
            __builtin_amdgcn_fence(__ATOMIC_ACQUIRE, "agent");
            asm volatile("s_waitcnt vmcnt(0)" ::: "memory");
        }
    }
    __syncthreads();
}

constexpr int NPHASE = 16;
struct MArgs { Ptrs p; int ph_lo, ph_hi; };
__global__ void __launch_bounds__(NTHR, 2) mega(MArgs a) {
    extern __shared__ __attribute__((aligned(16))) unsigned char lds_raw[];
    LAS unsigned char* lds = (LAS unsigned char*)lds_raw;
    const Ptrs& p = a.p;
    const int tid = otid(), lane = tid & 63, wave = __builtin_amdgcn_readfirstlane(tid >> 6);
    const int G = gridDim.x, bx = blockIdx.x, vcu = (G % 8 == 0) ? (bx % 8) * (G / 8) + bx / 8 : bx;
    const int lo = a.ph_lo, hi = a.ph_hi;
    cg::grid_group grid = cg::this_grid();
    volatile LAS unsigned* bst = (volatile LAS unsigned*)(lds + LDS_BYTES - 32);
    if (tid == 0) { bst[0] = 0u; bst[1] = 0u; }
    __syncthreads();
    const XcdBarrier xbar = xcd_barrier_post((unsigned*)(p.ws + WS_CTL) + 1024, bst);
#define IN(k) (lo <= (k) && (k) < hi)
#define SEAM(k) do { if (IN(k) && IN((k) + 1)) { if ((k) == 0) grid.sync(); else xcd_barrier(xbar); } } while (0)
    const int NGW = G * NWAVES;
#ifndef NO_PREP
    if (IN(0)) phase_prep(p, lds, vcu, G, tid, wave, lane);
#endif
    SEAM(0);
    if (IN(1)) { const int t1 = otid(); for (int r = vcu * NWAVES + (t1 >> 6); r < R; r += NGW) row_pass(p, r, t1 & 63, 0, nullptr, nullptr, 0, 0); }
    SEAM(1);
    bf16* BUFA = (bf16*)(p.ws + WS_BUFA); bf16* BUFB = (bf16*)(p.ws + WS_BUFB); bf16* BIG = (bf16*)(p.ws + WS_BIG);
    for (int s = 0; s < 14; ++s) {
        const int ph = s + 2, l = s / 7, k = s % 7;
        if (IN(ph)) {
            const int nM = l ? 64 : 72;
            if (k == 0) {
                pg8::Gemm g{BUFA, (const bf16*)(p.ws + (l ? WS_WIN1 : WS_WIN0)), 0, 0, D};
                TileSched S; if (l == 0) S.init(72, 6, G, bx, 0, 0); else S.init(64, 11, G, bx, 1, 48);
                EpiIn E{&p, l};
#ifndef NO_GIN
                pg8::gemm_phase<EpiIn, TileSched, true, true>(lds, g, S, E);
#endif
            } else if (k == 1) {
#ifndef NO_MIX0
                if (l == 0) phase_mix0(p, lds, vcu);
#endif
#ifndef NO_MIX1
                if (l == 1) phase_mix1(p, lds, vcu);
#endif
            } else if (k == 2 || k == 5) {
                pg8::Gemm g{k == 2 ? BUFB : BIG, k == 2 ? (const bf16*)(p.ws + (l ? WS_WOUT1 : WS_WOUT0)) : (const bf16*)(p.ws + WS_WFOUT) + (size_t)l * D * FF, 0, 0, k == 2 ? D : FF};
                TileSched S; S.init(nM, 4, G, bx, l, 0);
                EpiRes E{&p, l, k == 2 ? 2048 : 5120, (k == 2 && l == 0) ? 1 : 0};
#ifndef NO_GRES
                pg8::gemm_phase<EpiRes, TileSched, true, true>(lds, g, S, E);
#endif
            } else if (k == 4) {
                pg8::Gemm g{BUFA, (const bf16*)(p.ws + WS_WFIN) + (size_t)l * 2 * FF * D, 0, 0, D};
                TileSched S; S.init(nM, 22, G, bx, l, 0);
                EpiFfn E{BIG};
#ifndef NO_GFFN
                pg8::gemm_phase<EpiFfn, TileSched, true, true>(lds, g, S, E);
#endif
            } else {
                const float* lg = (k == 3 ? p.ln1_g : p.ln2_g) + l * D; const float* lb = (k == 3 ? p.ln1_b : p.ln2_b) + l * D;
                const int hlayer = k == 3 ? l : l + 1, hoff = k == 3 ? 3072 : (l == 0 ? 0 : -1), nrows = l ? NB * SEQ : R;
                const int t1 = otid();
                for (int i = vcu * NWAVES + (t1 >> 6); i < nrows; i += NGW) { const int r = l ? (i / SEQ) * TOK + CTXL + i % SEQ : i; row_pass(p, r, t1 & 63, 1, lg, lb, hlayer, hoff); }
            }
        }
        SEAM(ph);
    }
#undef IN
#undef SEAM
}

#ifndef STAGES
#define STAGES "MMMMMMMMMMMMMMMM"
#endif
static void launch_naive(const Ptrs& p, int ph, hipStream_t stream) {
    bf16* BUFA = (bf16*)(p.ws + WS_BUFA); bf16* BUFB = (bf16*)(p.ws + WS_BUFB); bf16* BIG = (bf16*)(p.ws + WS_BIG);
    if (ph == 0) { n_prep<<<(2 * 9 * MODW + 1024 + 255) / 256, 256, 0, stream>>>(p); return; }
    if (ph == 1) { n_rowpass<<<1024, 256, 0, stream>>>(p, 0, 0, nullptr, nullptr, 0, 0); return; }
    const int l = (ph - 2) / 7, k = (ph - 2) % 7, rm = l ? 1 : 0, nrt = (l ? NB * SEQ : R) / 64;
    switch (k) {
    case 0: if (l == 0) { NG g = mk(BUFA, D, p.ab_w_in, P0, 0, EPI_IN0, 0, 0, 0, 0, BIG); n_gemm<<<dim3(24, nrt), 256, 0, stream>>>(p, g); }
            else { NG g = mk(BUFA, D, p.cd_w_in, CIN1, 1, EPI_IN1, 1, 0, 0, 0, BIG); n_gemm<<<dim3(40, nrt), 256, 0, stream>>>(p, g);
                   NG g2 = mk(BUFA, D, p.cd_w_in, CIN1, 2, EPI_IN1, 1, 12, 0, 0, BIG); n_gemm<<<dim3(24, NB * CTXL / 64), 256, 0, stream>>>(p, g2); } break;
    case 1: if (l == 0) { n_attn0<<<dim3(9, 12, NB), 256, 0, stream>>>(p); n_pool<<<R, 256, 0, stream>>>(p); }
            else { n_attn1<<<dim3(32, 6, NB), 256, 0, stream>>>(p); n_conv<<<NB * SEQ, 256, 0, stream>>>(p); } break;
    case 2: { NG g = mk(BUFB, D, l ? p.cd_w_out : p.ab_w_out, D, rm, EPI_RES, l, 0, l == 0, 2048, nullptr); n_gemm<<<dim3(16, nrt), 256, 0, stream>>>(p, g); } break;
    case 3: n_rowpass<<<1024, 256, 0, stream>>>(p, 1, rm, p.ln1_g + l * D, p.ln1_b + l * D, l, 3072); break;
    case 4: { NG g = mk(BUFA, D, p.ffn_w_in + (size_t)l * D * 2 * FF, 2 * FF, rm, EPI_FFN, l, 0, 0, 0, BIG); n_gemm<<<dim3(FF / 64, nrt), 256, 0, stream>>>(p, g); } break;
    case 5: { NG g = mk(BIG, FF, p.ffn_w_out + (size_t)l * FF * D, D, rm, EPI_RES, l, 0, 0, 5120, nullptr); n_gemm<<<dim3(16, nrt), 256, 0, stream>>>(p, g); } break;
    case 6: n_rowpass<<<1024, 256, 0, stream>>>(p, 1, rm, p.ln2_g + l * D, p.ln2_b + l * D, l + 1, l == 0 ? 0 : -1); break;
    }
}
extern "C" void kernel_launch(void* const* d_in, const int* in_sizes, int n_in, void* d_out, int out_size, void* d_ws, size_t ws_size, hipStream_t stream) {
    if (n_in != 29 || in_sizes[0] != NB * SEQ * D || out_size != NB * SEQ * D || ws_size < WS_END) { fprintf(stderr, "kernel_launch: unexpected shapes (n_in %d, ws %zu)\n", n_in, ws_size); return; }
    static int grid = 0;
    if (grid == 0) {
        int dev = 0, cus = 0, per_cu = 0;
        (void)hipGetDevice(&dev); (void)hipDeviceGetAttribute(&cus, hipDeviceAttributeMultiprocessorCount, dev);
        if (hipFuncSetAttribute((const void*)mega, hipFuncAttributeMaxDynamicSharedMemorySize, LDS_BYTES) != hipSuccess) { fprintf(stderr, "kernel_launch: hipFuncSetAttribute failed\n"); grid = -1; return; }
        (void)hipOccupancyMaxActiveBlocksPerMultiprocessor(&per_cu, (const void*)mega, NTHR, LDS_BYTES);
        if (per_cu < 1) { fprintf(stderr, "kernel_launch: occupancy query says %d blocks per CU\n", per_cu); grid = -1; return; }
        grid = cus;
        fprintf(stderr, "kernel_launch: %d CUs, occupancy %d per CU, grid %d\n", cus, per_cu, grid);
    }
    if (grid < 0) return;
    MArgs a; memset(&a, 0, sizeof(a));
    const float** f = (const float**)&a.p;
    for (int i = 0; i < 29; ++i) f[i] = (const float*)d_in[i];
    a.p.out = (float*)d_out; a.p.ws = (unsigned char*)d_ws;
    const char* st = STAGES;
    for (int ph = 0; ph < NPHASE;) {
        if (st[ph] == 'N') { launch_naive(a.p, ph, stream); ++ph; continue; }
        int e = ph; while (e < NPHASE && st[e] == 'M') ++e;
        a.ph_lo = ph; a.ph_hi = e;
        if (e - ph > 1 && hipMemsetAsync((char*)d_ws + WS_CTL, 0, 64 * 1024, stream) != hipSuccess) fprintf(stderr, "kernel_launch: memset failed\n");
        void* args[] = {&a};
        hipError_t err = hipLaunchCooperativeKernel((const void*)mega, dim3(grid), dim3(NTHR), args, LDS_BYTES, stream);
        if (err != hipSuccess) fprintf(stderr, "kernel_launch: cooperative launch failed: %s (grid %d)\n", hipGetErrorString(err), grid);
        ph = e;
    }
}
```

```cpp
#define PROBE_REP (1<<10)
#include <hip/hip_runtime.h>
#include <cstdio>
#include <cstdint>
#include <cmath>
#include <cstring>
#include <hip/hip_cooperative_groups.h>
namespace cg = cooperative_groups;

constexpr int D = 1024, NB = 8, SEQ = 2048, CTXL = 256, TOK = SEQ + CTXL, R = NB * TOK;
constexpr int FF = 2816, HD = 64;
constexpr int P0 = 1536;
constexpr int P1 = 2560;
constexpr int CIN1 = 2816;
constexpr float ALPHA = 1.4142135623730951f, LN_EPS = 1e-6f;
constexpr float QSCALE = 0.125f * 1.4426950408889634f;
constexpr float LAM_INIT = 0.35550906758f;
constexpr int MODW = 6 * D;

constexpr size_t MiB = 1u << 20;
constexpr size_t WS_CTL = 0, WS_MOD = 1 * MiB, WS_ROPE = WS_MOD + 2 * 9 * MODW * 4;
constexpr size_t WS_XC = 48 * MiB, WS_BUFA = 56 * MiB, WS_BUFB = 92 * MiB, WS_BIG = 128 * MiB;
constexpr size_t WS_STATS = 227 * MiB;
constexpr size_t WS_GVEC = WS_STATS + 3 * (size_t)R * 8;
constexpr size_t WS_GWBW = WS_GVEC + 3 * 9 * 1024 * 4;
constexpr int FOLD_N[3] = {2 * 2816, 2816, 2 * 2816};
constexpr size_t FOLD_BASE[3] = {0, 2 * 9 * 5632, 2 * 9 * 5632 + 2 * 9 * 2816};
constexpr size_t WS_END = 230 * MiB;
static_assert(WS_ROPE + 2 * 64 * 16 * 4 <= 2 * MiB, "ws map");

typedef unsigned short bf16;
__device__ __forceinline__ unsigned f2bf(float f) { unsigned u = __builtin_bit_cast(unsigned, f); return (u + 0x7fffu + ((u >> 16) & 1u)) >> 16; }
__device__ __forceinline__ float bf2f(unsigned short h) { return __builtin_bit_cast(float, (unsigned)h << 16); }
__device__ __forceinline__ float silu_f(float x) { return x / (1.f + __expf(-x)); }
__device__ __forceinline__ float sigmoid_f(float x) { return 1.f / (1.f + __expf(-x)); }

struct Ptrs {
    const float *x, *c, *ctx, *c_ctx, *ab_w_in, *ab_q_gain, *ab_k_gain, *ab_w_pool, *ab_pool_scale, *ab_w_out,
        *cd_w_in, *lq1, *lk1, *lq2, *lk2, *subln, *conv_w, *conv_b, *conv_ln_g, *conv_ln_b, *cd_w_out,
        *ada_w, *ada_b, *ln1_g, *ln1_b, *ln2_g, *ln2_b, *ffn_w_in, *ffn_w_out;
    float* out; unsigned char* ws;
};
__device__ __forceinline__ float* res_row(const Ptrs& p, int r) {
    const int b = r / TOK, tp = r % TOK;
    return tp < CTXL ? (float*)(p.ws + WS_XC) + (size_t)(b * CTXL + tp) * D : p.out + (size_t)(b * SEQ + tp - CTXL) * D;
}
__device__ __forceinline__ const float* in_row(const Ptrs& p, int r) {
    const int b = r / TOK, tp = r % TOK;
    return tp < CTXL ? p.ctx + (size_t)(b * CTXL + tp) * D : p.x + (size_t)(b * SEQ + tp - CTXL) * D;
}
__device__ __forceinline__ const float* mod_vec(const Ptrs& p, int layer, int r) {
    const int b = r / TOK, tp = r % TOK;
    return (const float*)(p.ws + WS_MOD) + (size_t)(layer * 9 + (tp < CTXL ? 8 : b)) * MODW;
}

__device__ __forceinline__ float wave_sum(float v) {
#pragma unroll
    for (int o = 1; o < 64; o <<= 1) v += __shfl_xor(v, o);
    return v;
}
__device__ __forceinline__ void row_pass(const Ptrs& p, int r, int lane, int mode, const float* lng, const float* lnb, int hlayer, int hoff) {
    float4 v[4];
    const float4* src = (const float4*)(mode == 0 ? in_row(p, r) : res_row(p, r));
#pragma unroll
    for (int j = 0; j < 4; ++j) v[j] = src[lane + 64 * j];
    if (mode == 1) {
        float s = 0.f;
#pragma unroll
        for (int j = 0; j < 4; ++j) s += (v[j].x + v[j].y) + (v[j].z + v[j].w);
        const float mean = wave_sum(s) * (1.f / D); float q = 0.f;
#pragma unroll
        for (int j = 0; j < 4; ++j) { v[j].x -= mean; v[j].y -= mean; v[j].z -= mean; v[j].w -= mean; q += (v[j].x * v[j].x + v[j].y * v[j].y) + (v[j].z * v[j].z + v[j].w * v[j].w); }
        const float rstd = 1.f / sqrtf(wave_sum(q) * (1.f / D) + LN_EPS);
        float4* dst = (float4*)res_row(p, r);
#pragma unroll
        for (int j = 0; j < 4; ++j) { const float4 g = ((const float4*)lng)[lane + 64 * j], b = ((const float4*)lnb)[lane + 64 * j];
            v[j].x = v[j].x * rstd * g.x + b.x; v[j].y = v[j].y * rstd * g.y + b.y; v[j].z = v[j].z * rstd * g.z + b.z; v[j].w = v[j].w * rstd * g.w + b.w; dst[lane + 64 * j] = v[j]; }
    }
    if (hoff >= 0) {
        const float* mv = mod_vec(p, hlayer, r); const float4* sh = (const float4*)(mv + hoff); const float4* sc = (const float4*)(mv + hoff + D);
        uint2* dst = (uint2*)((bf16*)(p.ws + WS_BUFA) + (size_t)r * D);
#pragma unroll
        for (int j = 0; j < 4; ++j) { const float4 a = sh[lane + 64 * j], s = sc[lane + 64 * j];
            const float h0 = v[j].x * (1.f + s.x) + a.x, h1 = v[j].y * (1.f + s.y) + a.y, h2 = v[j].z * (1.f + s.z) + a.z, h3 = v[j].w * (1.f + s.w) + a.w;
            dst[lane + 64 * j] = make_uint2(f2bf(h0) | (f2bf(h1) << 16), f2bf(h2) | (f2bf(h3) << 16)); }
    }
}
__device__ __forceinline__ int otid() { int t = threadIdx.x; asm volatile("" : "+v"(t)); return t; }
namespace pg8 {
#define PG8_LAS __attribute__((address_space(3)))
typedef unsigned short bf16_t;
typedef short bf16x8 __attribute__((ext_vector_type(8)));
typedef float f32x4 __attribute__((ext_vector_type(4)));
typedef unsigned u32x4 __attribute__((ext_vector_type(4)));
constexpr int BM = 256, BK = 64, HALF = 128, HTB = HALF * BK * 2  , STAGE_BYTES = 8 * HTB, NXCD = 8, WGM = 8;

__host__ __device__ __forceinline__ int lds_byte(int r, int c) { const int st = (r >> 4) * 2 + (c >> 5), rr = r & 15, cc = c & 31, ob = rr * 64 + cc * 2; return st * 1024 + (ob ^ (((ob >> 9) & 1) << 5)); }
__host__ __device__ __forceinline__ void stage_rc(int b, int& R, int& C) { const int st = b / 1024, sb = b % 1024, swz = sb ^ (((sb >> 9) & 1) << 5); R = (st >> 1) * 16 + swz / 64; C = (st & 1) * 32 + (swz % 64) / 2; }
__host__ __device__ __forceinline__ int perm32(int rho) { const int n = rho >> 4, i = rho & 15; return 8 * (i >> 2) + 4 * n + (i & 3); }

struct Unit { int pm, pn; };
struct Gemm { const bf16_t* A; const bf16_t* Bt; int M, N, K; };

__device__ __forceinline__ unsigned cvt_pk_bf16(float lo, float hi) { unsigned r; asm volatile("v_cvt_pk_bf16_f32 %0, %1, %2" : "=v"(r) : "v"(lo), "v"(hi)); return r; }
typedef float f32x2 __attribute__((ext_vector_type(2)));

template <class Epi, class Sched, bool ALIGN_EPI = false, bool SP2 = false>
__device__ __forceinline__ void gemm_phase(PG8_LAS unsigned char* lds, const Gemm g, const Sched& S, const Epi& E) {
    const int tid = otid(), wid = __builtin_amdgcn_readfirstlane(tid >> 6), lane = tid & 63, wr = wid >> 2, wc = wid & 3, fr = lane & 15, fq = lane >> 4;
    const int K = g.K, nt = K / BK;
    unsigned voffA[2], voffB[2];
#pragma unroll
    for (int i = 0; i < 2; ++i) { int R, C; stage_rc(tid * 16 + i * 8192, R, C); const int Rb = Epi::PERM ? ((R & ~31) + perm32(R & 31)) : R;
        voffA[i] = (unsigned)(R * K + C) * 2u; voffB[i] = (unsigned)(Rb * K + C) * 2u; }
    const size_t kstep = (size_t)(BK * 2);
    const size_t hstep = (size_t)HALF * K * 2;
    const size_t tstep = 2 * hstep;
    const unsigned ldsw = (unsigned)wid * 1024u;
    const int aoff = lds_byte(wr * 64 + fr, fq * 8), boff = lds_byte(wc * 32 + fr, fq * 8);
#define PG8_SA(b, h) (((b) * 2 + (h)) * HTB)
#define PG8_SB(b, h) ((4 + (b) * 2 + (h)) * HTB)
#define PG8_STAGE(bufoff, gbase, voff) do { _Pragma("unroll") for (int _i = 0; _i < 2; ++_i) \
        __builtin_amdgcn_global_load_lds((const unsigned*)((const char*)(gbase) + (voff)[_i]), (PG8_LAS unsigned*)(lds + (bufoff) + ldsw + _i * 8192), 16, 0, 0); } while (0)
#define PG8_LDA(dst, b, h) do { _Pragma("unroll") for (int m = 0; m < 4; ++m) _Pragma("unroll") for (int k = 0; k < 2; ++k) dst[m][k] = *(const PG8_LAS bf16x8*)(lds + PG8_SA(b, h) + aoff + m * 2048 + k * 1024); } while (0)
#define PG8_LDB(dst, b, h) do { _Pragma("unroll") for (int n = 0; n < 2; ++n) _Pragma("unroll") for (int k = 0; k < 2; ++k) dst[n][k] = *(const PG8_LAS bf16x8*)(lds + PG8_SB(b, h) + boff + n * 2048 + k * 1024); } while (0)
#define PG8_MMA(ai, bj, At, Bt) do { __builtin_amdgcn_s_setprio(1); _Pragma("unroll") for (int m = 0; m < 4; ++m) _Pragma("unroll") for (int n = 0; n < 2; ++n) _Pragma("unroll") for (int k = 0; k < 2; ++k) \
        acc[ai][bj][m][n] = __builtin_amdgcn_mfma_f32_16x16x32_bf16(Bt[n][k], At[m][k], acc[ai][bj][m][n], 0, 0, 0); __builtin_amdgcn_s_setprio(0); } while (0)
#define PG8_WAIT_V(n) asm volatile("s_waitcnt vmcnt(" #n ")" ::: "memory")
#define PG8_WAIT_L(n) asm volatile("s_waitcnt lgkmcnt(" #n ")" ::: "memory")
#define PG8_BAR __builtin_amdgcn_s_barrier()
#define PG8_SCHED __builtin_amdgcn_sched_barrier(0)
    Unit cur, nxt; int ui = 0;
    if (!S.next(0, cur)) return;
    f32x4 acc[2][2][4][2];
#pragma unroll
    for (int a = 0; a < 2; ++a)
#pragma unroll
        for (int b = 0; b < 2; ++b)
#pragma unroll
            for (int m = 0; m < 4; ++m)
#pragma unroll
                for (int n = 0; n < 2; ++n) acc[a][b][m][n] = (f32x4){0.f, 0.f, 0.f, 0.f};
    bf16x8 At[4][2], B0[2][2], B1[2][2];
    const char* cA = (const char*)g.A + (size_t)cur.pm * tstep; const char* cB = (const char*)g.Bt + (size_t)cur.pn * tstep;
    S.a_ready(cur);
    if constexpr (SP2) {
        PG8_STAGE(PG8_SB(0, 0), cB, voffB); PG8_STAGE(PG8_SB(0, 1), cB + hstep, voffB); PG8_STAGE(PG8_SA(0, 0), cA, voffA); PG8_STAGE(PG8_SA(0, 1), cA + hstep, voffA);
        if (wr == 1) PG8_BAR;
        PG8_WAIT_V(2); PG8_BAR;
        PG8_STAGE(PG8_SB(1, 0), cB + kstep, voffB); PG8_STAGE(PG8_SA(1, 0), cA + kstep, voffA); PG8_STAGE(PG8_SB(1, 1), cB + hstep + kstep, voffB);
        PG8_WAIT_V(6); PG8_BAR;
    } else {
        PG8_STAGE(PG8_SB(0, 0), cB, voffB); PG8_STAGE(PG8_SA(0, 0), cA, voffA); PG8_STAGE(PG8_SB(0, 1), cB + hstep, voffB); PG8_STAGE(PG8_SA(0, 1), cA + hstep, voffA);
        if (wr == 1) PG8_BAR;
        PG8_WAIT_V(4); PG8_BAR;
        PG8_STAGE(PG8_SB(1, 0), cB + kstep, voffB); PG8_STAGE(PG8_SA(1, 0), cA + kstep, voffA); PG8_STAGE(PG8_SB(1, 1), cB + hstep + kstep, voffB);
        PG8_WAIT_V(6); PG8_BAR;
    }
    for (;;) {
        const bool has_next = S.next(ui + 1, nxt);
        const char* nA = has_next ? (const char*)g.A + (size_t)nxt.pm * tstep : cA; const char* nB = has_next ? (const char*)g.Bt + (size_t)nxt.pn * tstep : cB;
        for (int t = 0; t < nt; t += 2) {
            const bool last = (t == nt - 2);
            const char* a1 = cA + (size_t)(t + 1) * kstep;
            const char* a2 = last ? nA : cA + (size_t)(t + 2) * kstep; const char* b2 = last ? nB : cB + (size_t)(t + 2) * kstep;
            const char* a3 = a2 + kstep; const char* b3 = b2 + kstep;
            if (last && has_next) S.a_ready(nxt);
            if constexpr (SP2) {
            PG8_LDB(B0, 0, 0); PG8_LDB(B1, 0, 1); PG8_SCHED; PG8_LDA(At, 0, 0); PG8_STAGE(PG8_SA(1, 1), a1 + hstep, voffA);
            PG8_WAIT_V(8); PG8_WAIT_L(0); PG8_BAR; PG8_MMA(0, 0, At, B0); PG8_MMA(0, 1, At, B1); PG8_BAR; PG8_SCHED;
            PG8_LDA(At, 0, 1); PG8_STAGE(PG8_SB(0, 0), b2, voffB); PG8_STAGE(PG8_SB(0, 1), b2 + hstep, voffB); PG8_STAGE(PG8_SA(0, 0), a2, voffA);
            PG8_WAIT_V(8); PG8_WAIT_L(0); PG8_BAR; PG8_MMA(1, 0, At, B0); PG8_MMA(1, 1, At, B1); PG8_BAR; PG8_SCHED;
            PG8_LDB(B0, 1, 0); PG8_LDB(B1, 1, 1); PG8_SCHED; PG8_LDA(At, 1, 0); PG8_STAGE(PG8_SA(0, 1), a2 + hstep, voffA);
            PG8_WAIT_V(8); PG8_WAIT_L(0); PG8_BAR; PG8_MMA(0, 0, At, B0); PG8_MMA(0, 1, At, B1); PG8_BAR; PG8_SCHED;
            PG8_LDA(At, 1, 1); PG8_STAGE(PG8_SB(1, 0), b3, voffB); PG8_STAGE(PG8_SB(1, 1), b3 + hstep, voffB); PG8_STAGE(PG8_SA(1, 0), a3, voffA);
            PG8_WAIT_V(8); PG8_WAIT_L(0); PG8_BAR; PG8_MMA(1, 0, At, B0); PG8_MMA(1, 1, At, B1); PG8_BAR; PG8_SCHED;
            } else {
            PG8_LDB(B0, 0, 0); PG8_SCHED; PG8_LDA(At, 0, 0); PG8_STAGE(PG8_SA(1, 1), a1 + hstep, voffA);
            PG8_WAIT_L(8); PG8_BAR; PG8_WAIT_L(0); PG8_MMA(0, 0, At, B0); PG8_BAR; PG8_SCHED;
            PG8_LDB(B1, 0, 1); PG8_STAGE(PG8_SB(0, 0), b2, voffB);
            PG8_BAR; PG8_WAIT_L(0); PG8_MMA(0, 1, At, B1); PG8_BAR;
            PG8_LDA(At, 0, 1); PG8_STAGE(PG8_SA(0, 0), a2, voffA);
            PG8_BAR; PG8_WAIT_L(0); PG8_MMA(1, 0, At, B0); PG8_BAR; PG8_SCHED;
            PG8_STAGE(PG8_SB(0, 1), b2 + hstep, voffB);
            PG8_WAIT_V(6); PG8_BAR; PG8_MMA(1, 1, At, B1); PG8_BAR;
            PG8_LDB(B0, 1, 0); PG8_SCHED; PG8_LDA(At, 1, 0); PG8_STAGE(PG8_SA(0, 1), a2 + hstep, voffA);
            PG8_WAIT_L(8); PG8_BAR; PG8_WAIT_L(0); PG8_MMA(0, 0, At, B0); PG8_BAR; PG8_SCHED;
            PG8_LDB(B1, 1, 1); PG8_STAGE(PG8_SB(1, 0), b3, voffB);
            PG8_BAR; PG8_WAIT_L(0); PG8_MMA(0, 1, At, B1); PG8_BAR;
            PG8_LDA(At, 1, 1); PG8_STAGE(PG8_SA(1, 0), a3, voffA);
            PG8_BAR; PG8_WAIT_L(0); PG8_MMA(1, 0, At, B0); PG8_BAR; PG8_SCHED;
            PG8_STAGE(PG8_SB(1, 1), b3 + hstep, voffB);
            PG8_WAIT_V(6); PG8_BAR; PG8_MMA(1, 1, At, B1); PG8_BAR;
            }
        }
        if constexpr (ALIGN_EPI) { if (wr == 0) PG8_BAR; }
        if constexpr (!Epi::AFTER_DRAIN) { E(acc, cur, wr, wc, fr, fq); S.done(cur); }
        if (!has_next) break;
#pragma unroll
        for (int a = 0; a < 2; ++a)
#pragma unroll
            for (int b = 0; b < 2; ++b)
#pragma unroll
                for (int m = 0; m < 4; ++m)
#pragma unroll
                    for (int n = 0; n < 2; ++n) acc[a][b][m][n] = (f32x4){0.f, 0.f, 0.f, 0.f};
        cur = nxt; cA = nA; cB = nB; ++ui;
        if constexpr (ALIGN_EPI) { if (wr == 1) PG8_BAR; }
    }
    PG8_WAIT_V(0);
    if constexpr (!ALIGN_EPI) { if (wr == 0) PG8_BAR; }
    PG8_BAR;
    if constexpr (Epi::AFTER_DRAIN) { E.fused(acc, cur, wr, wc, fr, fq, lds, wid, lane); S.done(cur); }
#undef PG8_SA
#undef PG8_SB
#undef PG8_STAGE
#undef PG8_LDA
#undef PG8_LDB
#undef PG8_MMA
#undef PG8_WAIT_V
#undef PG8_WAIT_L
#undef PG8_BAR
#undef PG8_SCHED
}
}

#define LAS __attribute__((address_space(3)))
typedef float f32x4 __attribute__((ext_vector_type(4)));
typedef unsigned u32x4 __attribute__((ext_vector_type(4)));
typedef unsigned u32x2 __attribute__((ext_vector_type(2)));
typedef float f32x2 __attribute__((ext_vector_type(2)));
constexpr int NWAVES = 8, NTHR = 512;
constexpr size_t WS_WIN0 = 2 * MiB, WS_WOUT0 = 5 * MiB, WS_WIN1 = 7 * MiB, WS_WOUT1 = 12 * MiB + 512 * 1024, WS_WFIN = 14 * MiB + 512 * 1024, WS_WFOUT = 36 * MiB + 512 * 1024;
static_assert(WS_WFOUT + 2 * (size_t)D * FF * 2 <= WS_XC, "weights fit below XC");
constexpr int LDS_BYTES = 147456;

__device__ __forceinline__ float fast_rcp(float x) { return __builtin_amdgcn_rcpf(x); }
__device__ __forceinline__ float silu_fast(float x) { return x * fast_rcp(1.f + __builtin_amdgcn_exp2f(-1.4426950408889634f * x)); }
__device__ __forceinline__ float sigmoid_fast(float x) { return fast_rcp(1.f + __builtin_amdgcn_exp2f(-1.4426950408889634f * x)); }

__device__ __forceinline__ int srccol(int kind, int n0) {
    const int t = n0 >> 8, p = n0 & 255;
    if (kind == 0) return n0;
    if (kind == 1 || (kind == 2 && n0 < 2304)) return t * 256 + 64 * ((p >> 5) & 3) + 32 * (p >> 7);
    if (kind == 2) return 2304 + (p >> 7) * 256 + 128 * (t - 9) + (p & 127);
    return (p >> 7) * FF + 128 * t + (p & 127);
}
__device__ __forceinline__ unsigned pk2(float lo, float hi) { return f2bf(lo) | (f2bf(hi) << 16); }
__device__ __forceinline__ void transpose_item(const float* W, int K, int N, bf16* WT, int kind, LAS float* scr, int item, int lane) {
    const int nblk = N / 32, kb = item / nblk, nb = item % nblk, k0 = 64 * kb, n0 = 32 * nb, s0 = srccol(kind, n0);
#pragma unroll 8
    for (int i = 0; i < 32; ++i) { const int kk = 2 * i + (lane >> 5); scr[kk * 33 + (lane & 31)] = W[(size_t)(k0 + kk) * N + s0 + (lane & 31)]; }
    asm volatile("s_waitcnt lgkmcnt(0)" ::: "memory");
    const int c = lane & 7;
#pragma unroll
    for (int j = 0; j < 4; ++j) { const int n = (lane >> 3) + 8 * j; const LAS float* s = scr + (8 * c) * 33 + n;
        u32x4 o; o.x = pk2(s[0 * 33], s[1 * 33]); o.y = pk2(s[2 * 33], s[3 * 33]); o.z = pk2(s[4 * 33], s[5 * 33]); o.w = pk2(s[6 * 33], s[7 * 33]);
        *(u32x4*)(WT + (size_t)(n0 + n) * K + k0 + 8 * c) = o; }
    asm volatile("s_waitcnt lgkmcnt(0)" ::: "memory");
}
__device__ __forceinline__ void vecmat256(const float* W, int ldw, int c0, LAS const float* T, LAS float* part, float* out, int ldo, const float* bias, int tid) {
    const int wave = tid >> 6, lane = tid & 63;
    const float* Wp = W + c0 + 4 * lane;
    f32x4 acc[9];
#pragma unroll
    for (int v = 0; v < 9; ++v) acc[v] = (f32x4){0.f, 0.f, 0.f, 0.f};
#pragma unroll 4
    for (int kk = 0; kk < 128; ++kk) { const int k = wave * 128 + kk; const f32x4 w = *(const f32x4*)(Wp + (size_t)k * ldw);
#pragma unroll
        for (int v = 0; v < 9; ++v) acc[v] += w * T[v * 1024 + k]; }
#pragma unroll
    for (int v = 0; v < 9; ++v) *(LAS f32x4*)(part + (wave * 9 + v) * 256 + 4 * lane) = acc[v];
    __syncthreads();
    for (int e = tid; e < 9 * 256; e += NTHR) { const int v = e >> 8, c = e & 255; float sum = 0.f;
#pragma unroll
        for (int w = 0; w < 8; ++w) sum += part[(w * 9 + v) * 256 + c];
        out[(size_t)v * ldo + c0 + c] = sum + (bias ? bias[c0 + c] : 0.f); }
    __syncthreads();
}
__device__ __forceinline__ void phase_prep(const Ptrs& p, LAS unsigned char* lds, int vcu, int G, int tid, int wave, int lane) {
    {
        LAS float* scr = (LAS float*)(lds + wave * 16384);
        const int gw = vcu * NWAVES + wave, NGW = G * NWAVES;
        constexpr int I0 = 16 * (P0 / 32), I1 = 16 * (D / 32), I2 = 16 * (CIN1 / 32), I3 = I1, I4 = 16 * (2 * FF / 32), I5 = (FF / 64) * (D / 32);
        constexpr int NITEMS = I0 + I1 + I2 + I3 + 2 * I4 + 2 * I5;
        for (int it = gw; it < NITEMS; it += NGW) {
            int r = it;
            if (r < I0) { transpose_item(p.ab_w_in, D, P0, (bf16*)(p.ws + WS_WIN0), 1, scr, r, lane); continue; } r -= I0;
            if (r < I1) { transpose_item(p.ab_w_out, D, D, (bf16*)(p.ws + WS_WOUT0), 0, scr, r, lane); continue; } r -= I1;
            if (r < I2) { transpose_item(p.cd_w_in, D, CIN1, (bf16*)(p.ws + WS_WIN1), 2, scr, r, lane); continue; } r -= I2;
            if (r < I3) { transpose_item(p.cd_w_out, D, D, (bf16*)(p.ws + WS_WOUT1), 0, scr, r, lane); continue; } r -= I3;
            if (r < 2 * I4) { const int l = r / I4; transpose_item(p.ffn_w_in + (size_t)l * D * 2 * FF, D, 2 * FF, (bf16*)(p.ws + WS_WFIN) + (size_t)l * 2 * FF * D, 3, scr, r % I4, lane); continue; } r -= 2 * I4;
            { const int l = r / I5; transpose_item(p.ffn_w_out + (size_t)l * FF * D, FF, D, (bf16*)(p.ws + WS_WFOUT) + (size_t)l * D * FF, 0, scr, r % I5, lane); }
        }
    }
    __syncthreads();
    if (vcu < 48) {
        LAS float* T = (LAS float*)lds; LAS float* part = (LAS float*)(lds + 9 * 1024 * 4);
        for (int e = tid; e < 9 * 1024; e += NTHR) { const int v = e >> 10, k = e & 1023; T[e] = silu_f(v < 8 ? p.c[v * D + k] : p.c_ctx[k]); }
        __syncthreads();
        const int l = vcu / 24, cb = (vcu % 24) * 256;
        vecmat256(p.ada_w + (size_t)l * D * MODW, MODW, cb, T, part, (float*)(p.ws + WS_MOD) + (size_t)l * 9 * MODW, MODW, p.ada_b + l * MODW, tid);
    } else {
        f32x4* st = (f32x4*)(p.ws + WS_STATS);
        for (int e = (vcu - 48) * NTHR + tid; e < 3 * R * 2 / 4; e += (G - 48) * NTHR) st[e] = (f32x4){0.f, 0.f, 0.f, 0.f};
        if (vcu == 48) for (int e = tid; e < 1024; e += NTHR) { const int pos = e / 16, i = e % 16; const double fr = pow(10000.0, -(2.0 * i) / 32.0), ang = (double)pos * fr;
            float* rope = (float*)(p.ws + WS_ROPE); rope[e] = (float)cos(ang); rope[1024 + e] = (float)sin(ang); }
    }
}
__device__ __forceinline__ void phase_fold(const Ptrs& p, LAS unsigned char* lds, int vcu, int tid) {
    if (vcu >= 110) return;
    const int f = vcu < 44 ? 0 : (vcu < 66 ? 1 : 2), j = vcu - (f == 0 ? 0 : (f == 1 ? 44 : 66)), kind = j & 1, cb = (j >> 1) * 256;
    const float* lng = f == 0 ? p.ln1_g : (f == 1 ? p.ln2_g : p.ln1_g + D); const float* lnb = f == 0 ? p.ln1_b : (f == 1 ? p.ln2_b : p.ln1_b + D);
    const int ml = f == 0 ? 0 : 1, sc_off = f == 1 ? 1024 : 4096, sh_off = f == 1 ? 0 : 3072;
    const float* W = f == 0 ? p.ffn_w_in : (f == 1 ? p.cd_w_in : p.ffn_w_in + (size_t)D * 2 * FF); const int N = f == 1 ? CIN1 : 2 * FF;
    LAS float* T = (LAS float*)lds; LAS float* part = (LAS float*)(lds + 9 * 1024 * 4);
    const float* mod = (const float*)(p.ws + WS_MOD) + (size_t)ml * 9 * MODW;
    for (int e = tid; e < 9 * 1024; e += NTHR) { const int v = e >> 10, k = e & 1023; const float sc = mod[v * MODW + sc_off + k], sh = mod[v * MODW + sh_off + k], g = lng[k] * (1.f + sc);
        T[e] = kind == 0 ? g : lnb[k] * (1.f + sc) + sh;
        if (kind == 0 && cb == 0) ((float*)(p.ws + WS_GVEC))[f * 9 * 1024 + e] = g; }
    __syncthreads();
    vecmat256(W, N, cb, T, part, (float*)(p.ws + WS_GWBW) + (f == 0 ? 0 : (f == 1 ? 2 * 9 * 5632 : 2 * 9 * 5632 + 2 * 9 * 2816)) + (size_t)kind * 9 * N, N, nullptr, tid);
}

struct TileSched {
    int nM, nN, nwg, G, c, mode, extra;
    __device__ __forceinline__ void init(int nM_, int nN_, int G_, int c_, int mode_, int extra_) { nM = nM_; nN = nN_; nwg = nM * nN; G = G_; c = c_; mode = mode_; extra = extra_; }
    __device__ __forceinline__ bool next(int i, pg8::Unit& u) const {
        const long L = (long)i * G + c; if (L >= nwg + extra) return false;
        if (L >= nwg) { const int e = (int)L - nwg; u.pm = (e / 6) * 9; u.pn = 3 + e % 6; return true; }
        int wgid = (int)L; { const int q = nwg / 8, r = nwg % 8, xcd = wgid % 8, off = wgid / 8; wgid = (xcd < r ? xcd * (q + 1) : r * (q + 1) + (xcd - r) * q) + off; }
        const int nig = 8 * nN, gid = wgid / nig, fm = gid * 8, gsz = (nM - fm) < 8 ? (nM - fm) : 8;
        const int lp = fm + ((wgid % nig) % gsz); u.pn = (wgid % nig) / gsz;
        u.pm = mode ? (lp >> 3) * 9 + 1 + (lp & 7) : lp; return true;
    }
    __device__ __forceinline__ void a_ready(const pg8::Unit&) const {}
    __device__ __forceinline__ void done(const pg8::Unit&) const {}
};
__device__ __forceinline__ void row_norm(const float* stats, size_t r, float& mu, float& rstd) {
    const f32x2 sv = *(const f32x2*)(stats + 2 * r); mu = sv.x * (1.f / D); rstd = 1.f / sqrtf(sv.y * (1.f / D) - mu * mu + LN_EPS);
}
template <int LAYER> struct EpiIn {
    static constexpr bool PERM = false, AFTER_DRAIN = false;
    const Ptrs* p;
    __device__ __forceinline__ void operator()(const f32x4 (&acc)[2][2][4][2], const pg8::Unit& u, int wr, int wc, int fr, int fq) const {
        constexpr int layer = LAYER;
        const int pn = u.pn, kind = layer == 0 ? (pn < 3 ? 0 : (pn == 3 ? 1 : 2)) : (pn < 3 ? 0 : (pn < 6 ? 1 : (pn < 9 ? 2 : 3)));
        const int pitch = layer == 0 ? P0 : P1, jrow = u.pm % 9; const bool lat = jrow != 0;
        bf16* O = (bf16*)(p->ws + WS_BIG);
        const float* rope = (const float*)(p->ws + WS_ROPE);
        int lrow = wr * 64 + fr; asm volatile("" : "+v"(lrow));
        const int cnat0 = kind < 3 ? pn * 256 + wc * 64 + 4 * fq : 2304 + (pn - 9) * 128 + wc * 32 + 4 * fq, cbj = kind < 3 ? 32 : 256;
        f32x4 gn[2][2], gw[2][2], bw[2][2];
        const float* gwb = (const float*)(p->ws + WS_GWBW) + FOLD_BASE[1] + (size_t)(lat ? u.pm / 9 : 8) * CIN1;
#pragma unroll
        for (int bj = 0; bj < 2; ++bj)
#pragma unroll
            for (int n = 0; n < 2; ++n) {
                gn[bj][n] = (layer == 0 && kind < 2) ? *(const f32x4*)((kind == 0 ? p->ab_q_gain : p->ab_k_gain) + bj * 32 + n * 16 + 4 * fq) : (f32x4){1.f, 1.f, 1.f, 1.f};
                if (layer == 1) { gw[bj][n] = *(const f32x4*)(gwb + cnat0 + bj * cbj + n * 16); bw[bj][n] = *(const f32x4*)(gwb + 9 * CIN1 + cnat0 + bj * cbj + n * 16); } }
#pragma unroll
        for (int ai = 0; ai < 2; ++ai)
#pragma unroll
            for (int m = 0; m < 4; ++m) {
                const int rr = ai * 128 + m * 16 + lrow; const size_t r = (size_t)u.pm * 256 + rr;
                f32x4 a[2][2];
#pragma unroll
                for (int bj = 0; bj < 2; ++bj)
#pragma unroll
                    for (int n = 0; n < 2; ++n) a[bj][n] = acc[ai][bj][m][n];
                if (layer == 1) { float mu, rstd; row_norm((const float*)(p->ws + WS_STATS) + (size_t)1 * R * 2, r, mu, rstd); const float mr = mu * rstd;
#pragma unroll
                    for (int bj = 0; bj < 2; ++bj)
#pragma unroll
                        for (int n = 0; n < 2; ++n) a[bj][n] = a[bj][n] * rstd - gw[bj][n] * mr + bw[bj][n]; }
                if (kind < 2) {
                    if (layer == 0) {
                        float ss = 0.f;
#pragma unroll
                        for (int bj = 0; bj < 2; ++bj)
#pragma unroll
                            for (int n = 0; n < 2; ++n) { const f32x4 x = a[bj][n]; ss += (x[0] * x[0] + x[1] * x[1]) + (x[2] * x[2] + x[3] * x[3]); }
                        ss += __shfl_xor(ss, 16); ss += __shfl_xor(ss, 32);
                        const float rs = 1.f / sqrtf(ss * (1.f / 64.f) + LN_EPS);
#pragma unroll
                        for (int bj = 0; bj < 2; ++bj)
#pragma unroll
                            for (int n = 0; n < 2; ++n) a[bj][n] = a[bj][n] * rs * gn[bj][n];
                    }
                    if (lat) {
                        const int t = (jrow - 1) * 256 + rr, prow = t >> 6, pcol = t & 63;
#pragma unroll
                        for (int bj = 0; bj < 2; ++bj) { const int pos = bj ? pcol : prow;
                            const f32x4 c4 = *(const f32x4*)(rope + pos * 16 + 4 * fq), s4 = *(const f32x4*)(rope + 1024 + pos * 16 + 4 * fq);
                            const f32x4 x1 = a[bj][0], x2 = a[bj][1]; a[bj][0] = x1 * c4 - x2 * s4; a[bj][1] = x2 * c4 + x1 * s4; }
                    }
                    if (kind == 0) {
#pragma unroll
                        for (int bj = 0; bj < 2; ++bj)
#pragma unroll
                            for (int n = 0; n < 2; ++n) a[bj][n] = a[bj][n] * QSCALE; }
                }
                if (kind < 3) {
                    bf16* o = O + r * pitch + pn * 256 + wc * 64 + 4 * fq;
#pragma unroll
                    for (int bj = 0; bj < 2; ++bj)
#pragma unroll
                        for (int n = 0; n < 2; ++n) { const f32x4 x = a[bj][n]; u32x2 w; w.x = pg8::cvt_pk_bf16(x[0], x[1]); w.y = pg8::cvt_pk_bf16(x[2], x[3]); *(u32x2*)(o + bj * 32 + n * 16) = w; }
                } else {
                    bf16* o = O + r * P1 + 2304 + (pn - 9) * 128 + wc * 32 + 4 * fq;
#pragma unroll
                    for (int n = 0; n < 2; ++n) { const f32x4 x = a[0][n], g = a[1][n]; u32x2 w;
                        w.x = pg8::cvt_pk_bf16(x[0] * sigmoid_fast(g[0]), x[1] * sigmoid_fast(g[1])); w.y = pg8::cvt_pk_bf16(x[2] * sigmoid_fast(g[2]), x[3] * sigmoid_fast(g[3])); *(u32x2*)(o + n * 16) = w; }
                }
            }
    }
};
struct EpiRes {
    static constexpr bool PERM = false, AFTER_DRAIN = false;
    const Ptrs* p; int layer, gate_off, xin_mode, sp, sc, fold; const float* lng; const float* lnb;
    __device__ __forceinline__ void operator()(const f32x4 (&acc)[2][2][4][2], const pg8::Unit& u, int wr, int wc, int fr, int fq) const {
        const int b = u.pm / 9, j = u.pm % 9; const bool isctx = j == 0; const int mv = isctx ? 8 : b;
        const float* gate = (const float*)(p->ws + WS_MOD) + (size_t)(layer * 9 + mv) * MODW + gate_off;
        float* resbase = isctx ? (float*)(p->ws + WS_XC) + (size_t)(b * CTXL) * D : p->out + (size_t)(b * SEQ + (j - 1) * 256) * D;
        const float* inbase = xin_mode == 0 ? (isctx ? p->ctx + (size_t)(b * CTXL) * D : p->x + (size_t)(b * SEQ + (j - 1) * 256) * D) : resbase;
        const float* gvec = (const float*)(p->ws + WS_GVEC) + (size_t)((fold < 0 ? 0 : fold) * 9 + mv) * 1024;
        const float* stp = (const float*)(p->ws + WS_STATS) + (size_t)(sp < 0 ? 0 : sp) * R * 2; float* stc = (float*)(p->ws + WS_STATS) + (size_t)(sc < 0 ? 0 : sc) * R * 2;
        bf16* An = (bf16*)(p->ws + WS_BUFA);
        const int col0 = u.pn * 256 + wc * 32 + 4 * fq; const size_t grow0 = (size_t)u.pm * 256;
        int lrow = wr * 64 + fr; asm volatile("" : "+v"(lrow));
#pragma unroll
        for (int ai = 0; ai < 2; ++ai) {
            float mu[4], rstd[4], ps[4], pss[4];
#pragma unroll
            for (int m = 0; m < 4; ++m) { ps[m] = 0.f; pss[m] = 0.f; mu[m] = 0.f; rstd[m] = 1.f; if (xin_mode) row_norm(stp, grow0 + ai * 128 + m * 16 + lrow, mu[m], rstd[m]); }
#pragma unroll
            for (int bj = 0; bj < 2; ++bj)
#pragma unroll
                for (int n = 0; n < 2; ++n) { const int c = col0 + bj * 128 + n * 16;
                    const f32x4 gv = *(const f32x4*)(gate + c), gf = fold >= 0 ? *(const f32x4*)(gvec + c) : (f32x4){0.f, 0.f, 0.f, 0.f};
                    const f32x4 gl = xin_mode ? *(const f32x4*)(lng + c) : (f32x4){1.f, 1.f, 1.f, 1.f}, bl = xin_mode ? *(const f32x4*)(lnb + c) : (f32x4){0.f, 0.f, 0.f, 0.f};
#pragma unroll
                    for (int m = 0; m < 4; ++m) { const size_t off = (size_t)(ai * 128 + m * 16 + lrow) * D + c;
                        f32x4 xin = *(const f32x4*)(inbase + off); if (xin_mode) xin = (xin - mu[m]) * rstd[m] * gl + bl;
                        const f32x4 v = xin * ALPHA + gv * acc[ai][bj][m][n];
                        *(f32x4*)(resbase + off) = v;
                        ps[m] += (v[0] + v[1]) + (v[2] + v[3]); pss[m] += (v[0] * v[0] + v[1] * v[1]) + (v[2] * v[2] + v[3] * v[3]);
                        if (fold >= 0) { const f32x4 h = v * gf; u32x2 w; w.x = pg8::cvt_pk_bf16(h[0], h[1]); w.y = pg8::cvt_pk_bf16(h[2], h[3]); *(u32x2*)(An + grow0 * D + off) = w; } } }
            if (sc >= 0) {
#pragma unroll
                for (int m = 0; m < 4; ++m) { float a = ps[m], q = pss[m]; a += __shfl_xor(a, 16); a += __shfl_xor(a, 32); q += __shfl_xor(q, 16); q += __shfl_xor(q, 32);
                    if (fq < 2) atomicAdd(stc + 2 * (grow0 + ai * 128 + m * 16 + lrow) + fq, fq ? q : a); } }
            asm volatile("" ::: "memory");
        }
    }
};
struct EpiFfn {
    static constexpr bool PERM = true, AFTER_DRAIN = false;
    const Ptrs* p; int fold, sp;
    __device__ __forceinline__ void operator()(const f32x4 (&acc)[2][2][4][2], const pg8::Unit& u, int wr, int wc, int fr, int fq) const {
        bf16* O = (bf16*)(p->ws + WS_BIG);
        const int h0 = u.pn * 128 + wc * 32 + 8 * fq, mv = (u.pm % 9) == 0 ? 8 : u.pm / 9;
        const float* gwb = (const float*)(p->ws + WS_GWBW) + (fold == 0 ? FOLD_BASE[0] : FOLD_BASE[2]) + (size_t)mv * 2 * FF;
        const float* stp = (const float*)(p->ws + WS_STATS) + (size_t)sp * R * 2;
        int lrow = wr * 64 + fr; asm volatile("" : "+v"(lrow));
        f32x4 gwa[2], bwa[2], gwg[2], bwg[2];
#pragma unroll
        for (int n = 0; n < 2; ++n) { gwa[n] = *(const f32x4*)(gwb + h0 + 4 * n); gwg[n] = *(const f32x4*)(gwb + FF + h0 + 4 * n);
            bwa[n] = *(const f32x4*)(gwb + 9 * 2 * FF + h0 + 4 * n); bwg[n] = *(const f32x4*)(gwb + 9 * 2 * FF + FF + h0 + 4 * n); }
#pragma unroll
        for (int ai = 0; ai < 2; ++ai)
#pragma unroll
            for (int m = 0; m < 4; ++m) { const size_t r = (size_t)u.pm * 256 + ai * 128 + m * 16 + lrow;
                float mu, rstd; row_norm(stp, r, mu, rstd); const float mr = mu * rstd;
                const f32x4 a0 = acc[ai][0][m][0] * rstd - gwa[0] * mr + bwa[0], a1 = acc[ai][0][m][1] * rstd - gwa[1] * mr + bwa[1];
                const f32x4 g0 = acc[ai][1][m][0] * rstd - gwg[0] * mr + bwg[0], g1 = acc[ai][1][m][1] * rstd - gwg[1] * mr + bwg[1]; u32x4 w;
                w.x = pg8::cvt_pk_bf16(silu_fast(g0[0]) * a0[0], silu_fast(g0[1]) * a0[1]); w.y = pg8::cvt_pk_bf16(silu_fast(g0[2]) * a0[2], silu_fast(g0[3]) * a0[3]);
                w.z = pg8::cvt_pk_bf16(silu_fast(g1[0]) * a1[0], silu_fast(g1[1]) * a1[1]); w.w = pg8::cvt_pk_bf16(silu_fast(g1[2]) * a1[2], silu_fast(g1[3]) * a1[3]);
                *(u32x4*)(O + r * FF + h0) = w; }
    }
};
namespace att {
typedef short bf16x8 __attribute__((ext_vector_type(8)));
typedef short s16x4 __attribute__((ext_vector_type(4)));
typedef float f32x16 __attribute__((ext_vector_type(16)));
#define SBAR() __builtin_amdgcn_sched_barrier(0)
constexpr float THR = 8.f;
__device__ __forceinline__ int crow(int r, int hi) { return (r & 3) + 8 * (r >> 2) + 4 * hi; }
__device__ __forceinline__ unsigned cvtpk(float lo, float hi) { unsigned r; asm volatile("v_cvt_pk_bf16_f32 %0, %1, %2" : "=v"(r) : "v"(lo), "v"(hi)); return r; }
__device__ __forceinline__ void partialSM(f32x16& p0, f32x16& p1, float& m_reg, float& mn, float& alpha) {
    float pmax = p0[0];
#pragma unroll
    for (int r = 1; r < 16; ++r) pmax = fmaxf(pmax, p0[r]);
#pragma unroll
    for (int r = 0; r < 16; ++r) pmax = fmaxf(pmax, p1[r]);
    { auto rr = __builtin_amdgcn_permlane32_swap(__float_as_uint(pmax), __float_as_uint(pmax), false, false); pmax = fmaxf(__uint_as_float(rr[0]), __uint_as_float(rr[1])); }
    if (__builtin_expect(__all(pmax - m_reg <= THR), 1)) { mn = m_reg; alpha = 1.f; }
    else { mn = fmaxf(m_reg, pmax); alpha = __builtin_amdgcn_exp2f(m_reg - mn); m_reg = mn; }
#pragma unroll
    for (int r = 0; r < 16; ++r) { p0[r] -= mn; p1[r] -= mn; }
#pragma unroll
    for (int r = 0; r < 16; ++r) p0[r] = __builtin_amdgcn_exp2f(p0[r]);
}
__device__ __forceinline__ void finishSM(f32x16& p0, f32x16& p1, float alpha, float& l_reg, bf16x8& pa0, bf16x8& pa1, bf16x8& pa2, bf16x8& pa3) {
#pragma unroll
    for (int r = 0; r < 16; ++r) p1[r] = __builtin_amdgcn_exp2f(p1[r]);
    float ps = 0;
#pragma unroll
    for (int r = 0; r < 16; ++r) ps += p0[r];
#pragma unroll
    for (int r = 0; r < 16; ++r) ps += p1[r];
    { auto rr = __builtin_amdgcn_permlane32_swap(__float_as_uint(ps), __float_as_uint(ps), false, false); ps = __uint_as_float(rr[0]) + __uint_as_float(rr[1]); }
    l_reg = l_reg * alpha + ps;
#define PK4(P, BASE, OUT) do { unsigned a0 = cvtpk(P[BASE + 0], P[BASE + 1]), a1 = cvtpk(P[BASE + 2], P[BASE + 3]);   \
    unsigned b0 = cvtpk(P[BASE + 4], P[BASE + 5]), b1 = cvtpk(P[BASE + 6], P[BASE + 7]);                              \
    auto r0 = __builtin_amdgcn_permlane32_swap(a0, b0, false, false); auto r1 = __builtin_amdgcn_permlane32_swap(a1, b1, false, false); \
    u32x4 w = {r0[0], r1[0], r0[1], r1[1]}; OUT = __builtin_bit_cast(bf16x8, w); } while (0)
    PK4(p0, 0, pa0); PK4(p0, 8, pa1); PK4(p1, 0, pa2); PK4(p1, 8, pa3);
#undef PK4
}
__device__ __forceinline__ int kswz(int row, int colB) { return row * 128 + (colB ^ (((row >> 1) & 7) << 4)); }
__device__ __forceinline__ void qkt(f32x16& p0, f32x16& p1, LAS const unsigned char* Ks, const bf16x8 (&qr)[4], int r32, int hi) {
    p0 = f32x16{}; p1 = f32x16{};
#pragma unroll
    for (int d0 = 0; d0 < 4; ++d0) { const int cb = d0 * 32 + hi * 16;
        const bf16x8 b0 = *(LAS const bf16x8*)(Ks + kswz(r32, cb));
        const bf16x8 b1 = *(LAS const bf16x8*)(Ks + kswz(32 + r32, cb));
        p0 = __builtin_amdgcn_mfma_f32_32x32x16_bf16(b0, qr[d0], p0, 0, 0, 0);
        p1 = __builtin_amdgcn_mfma_f32_32x32x16_bf16(b1, qr[d0], p1, 0, 0, 0); }
}
template <int DV> __device__ __forceinline__ int v_st(int k, int c) { const int kk = (k & ~0xC) | ((k & 4) << 1) | ((k & 8) >> 1); return ((kk >> 3) * (DV / 32) + (c >> 5)) * 512 + ((kk & 7) * 32 + (c & 31)) * 2; }
__device__ __forceinline__ int v_rd_base(int lane) { return ((lane & 3) << 3) | (((lane >> 2) & 3) << 6) | (((lane >> 4) & 1) << 5) | (((lane >> 5) & 1) << 8); }
template <int DV> constexpr int v_rd_off(int d0, int ks, int half) { return d0 * 512 + ks * (2 * (DV / 32) * 512) + half * ((DV / 32) * 512); }
template <int OFF> __device__ __forceinline__ s16x4 tr_read(int vb) { s16x4 r; asm volatile("ds_read_b64_tr_b16 %0, %1 offset:%2" : "=&v"(r) : "v"(vb), "i"(OFF) : "memory"); return r; }
template <int DV, int D0> __device__ __forceinline__ void pv_one(f32x16& od, int vb, bf16x8 pa0, bf16x8 pa1, bf16x8 pa2, bf16x8 pa3) {
    const s16x4 l0 = tr_read<v_rd_off<DV>(D0, 0, 0)>(vb), h0 = tr_read<v_rd_off<DV>(D0, 0, 1)>(vb), l1 = tr_read<v_rd_off<DV>(D0, 1, 0)>(vb), h1 = tr_read<v_rd_off<DV>(D0, 1, 1)>(vb);
    const s16x4 l2 = tr_read<v_rd_off<DV>(D0, 2, 0)>(vb), h2 = tr_read<v_rd_off<DV>(D0, 2, 1)>(vb), l3 = tr_read<v_rd_off<DV>(D0, 3, 0)>(vb), h3 = tr_read<v_rd_off<DV>(D0, 3, 1)>(vb);
    asm volatile("s_waitcnt lgkmcnt(0)" ::: "memory"); SBAR();
#define PK(L, H) (bf16x8){L[0], L[1], L[2], L[3], H[0], H[1], H[2], H[3]}
    od = __builtin_amdgcn_mfma_f32_32x32x16_bf16(pa0, PK(l0, h0), od, 0, 0, 0);
    od = __builtin_amdgcn_mfma_f32_32x32x16_bf16(pa1, PK(l1, h1), od, 0, 0, 0);
    od = __builtin_amdgcn_mfma_f32_32x32x16_bf16(pa2, PK(l2, h2), od, 0, 0, 0);
    od = __builtin_amdgcn_mfma_f32_32x32x16_bf16(pa3, PK(l3, h3), od, 0, 0, 0);
#undef PK
}
template <int DV> __device__ __forceinline__ void pv_all(f32x16 (&o)[DV / 32], int vb, bf16x8 pa0, bf16x8 pa1, bf16x8 pa2, bf16x8 pa3) {
    pv_one<DV, 0>(o[0], vb, pa0, pa1, pa2, pa3); pv_one<DV, 1>(o[1], vb, pa0, pa1, pa2, pa3);
    if constexpr (DV == 128) { pv_one<DV, 2>(o[2], vb, pa0, pa1, pa2, pa3); pv_one<DV, 3>(o[3], vb, pa0, pa1, pa2, pa3); }
}
template <int NKT, int DV> struct Cfg { static constexpr int KB = 8192, VB = 64 * DV * 2, BUF = NKT * KB + VB, SCR = 2 * BUF, TOTAL = SCR + NWAVES * 256; };
template <int NKT, int DV>
__device__ __forceinline__ void attn_unit(const bf16* Qw, const bf16* const (&Kg)[NKT], const bf16* Vg, int ld, int NT, int kidx, LAS unsigned char* lds, f32x16 (&o)[DV / 32], float& l_out) {
    typedef Cfg<NKT, DV> C;
    const int tid = otid(), wid = tid >> 6, lane = tid & 63, r32 = lane & 31, hi = lane >> 5;
    LAS float* al_l = (LAS float*)(lds + C::SCR) + wid * 64;
    float m_reg = -1e30f, l_reg = 0.f;
#pragma unroll
    for (int d = 0; d < DV / 32; ++d) o[d] = f32x16{};
    bf16x8 qr[4];
#pragma unroll
    for (int d0 = 0; d0 < 4; ++d0) qr[d0] = *(const bf16x8*)(Qw + d0 * 16);
    const int krow = tid >> 3, kch = tid & 7, kst = kswz(krow, kch * 16);
    const int vrow = DV == 64 ? (tid >> 3) : (tid >> 4), vcol = DV == 64 ? (tid & 7) * 8 : (tid & 15) * 8;
    const int vst0 = v_st<DV>(vrow, vcol), vst1 = v_st<DV>(32 + vrow, vcol);
    const int vb0 = (int)(uintptr_t)(lds + NKT * C::KB) + v_rd_base(lane);
    struct { bf16x8 k[NKT]; bf16x8 v[DV / 64]; } sr_[2];
#define SLOAD(i, k0) do { _Pragma("unroll") for (int kt = 0; kt < NKT; ++kt) sr_[i].k[kt] = *(const bf16x8*)(Kg[kt] + (size_t)((k0) + krow) * ld + kch * 8); \
        sr_[i].v[0] = *(const bf16x8*)(Vg + (size_t)((k0) + vrow) * ld + vcol); if constexpr (DV == 128) sr_[i].v[1] = *(const bf16x8*)(Vg + (size_t)((k0) + 32 + vrow) * ld + vcol); } while (0)
#define SWRITE(b, i) do { _Pragma("unroll") for (int kt = 0; kt < NKT; ++kt) *(LAS bf16x8*)(lds + (b) * C::BUF + kt * C::KB + kst) = sr_[i].k[kt]; \
        *(LAS bf16x8*)(lds + (b) * C::BUF + NKT * C::KB + vst0) = sr_[i].v[0]; if constexpr (DV == 128) *(LAS bf16x8*)(lds + (b) * C::BUF + NKT * C::KB + vst1) = sr_[i].v[1]; } while (0)
#define SWAIT() do { if constexpr (NKT + DV / 64 == 2) asm volatile("s_waitcnt vmcnt(2)" ::: "memory"); else asm volatile("s_waitcnt vmcnt(4)" ::: "memory"); } while (0)
#define RESC(a) do { if (__any((a) < 1.f)) { if (hi == 0) al_l[r32] = (a); asm volatile("s_waitcnt lgkmcnt(0)" ::: "memory"); \
        _Pragma("unroll") for (int d = 0; d < DV / 32; ++d) _Pragma("unroll") for (int r = 0; r < 16; ++r) o[d][r] *= al_l[crow(r, hi)]; } } while (0)
    f32x16 pA0, pA1, pB0, pB1; float mnA, mnB, alA, alB; bf16x8 pa0, pa1, pa2, pa3;
    LAS const unsigned char* K0 = lds + kidx * C::KB; LAS const unsigned char* K1 = lds + C::BUF + kidx * C::KB;
    SLOAD(0, 0); asm volatile("s_waitcnt vmcnt(0)" ::: "memory"); SWRITE(0, 0); __syncthreads();
    qkt(pA0, pA1, K0, qr, r32, hi); partialSM(pA0, pA1, m_reg, mnA, alA);
    SLOAD(1, 64); if (2 < NT) SLOAD(0, 128);
    SWAIT(); SWRITE(1, 1); __syncthreads();
    for (int j = 1; j + 1 < NT; j += 2) {
        SBAR(); qkt(pB0, pB1, K1, qr, r32, hi);
        finishSM(pA0, pA1, alA, l_reg, pa0, pa1, pa2, pa3); SBAR();
        SLOAD(1, (j + 2) * 64); SBAR();
        pv_all<DV>(o, vb0, pa0, pa1, pa2, pa3); partialSM(pB0, pB1, m_reg, mnB, alB);
        __syncthreads(); SWAIT(); SWRITE(0, 0);
        RESC(alB); __syncthreads();
        SBAR(); qkt(pA0, pA1, K0, qr, r32, hi);
        finishSM(pB0, pB1, alB, l_reg, pa0, pa1, pa2, pa3); SBAR();
        if (j + 3 < NT) SLOAD(0, (j + 3) * 64); SBAR();
        pv_all<DV>(o, vb0 + C::BUF, pa0, pa1, pa2, pa3); partialSM(pA0, pA1, m_reg, mnA, alA);
        __syncthreads(); SWAIT(); SWRITE(1, 1);
        RESC(alA); __syncthreads();
    }
    SBAR(); qkt(pB0, pB1, K1, qr, r32, hi);
    finishSM(pA0, pA1, alA, l_reg, pa0, pa1, pa2, pa3); SBAR();
    pv_all<DV>(o, vb0, pa0, pa1, pa2, pa3); partialSM(pB0, pB1, m_reg, mnB, alB);
    __syncthreads(); RESC(alB);
    finishSM(pB0, pB1, alB, l_reg, pa0, pa1, pa2, pa3); SBAR();
    pv_all<DV>(o, vb0 + C::BUF, pa0, pa1, pa2, pa3);
    l_out = l_reg;
#undef SLOAD
#undef SWRITE
#undef SWAIT
#undef RESC
}
#undef SBAR
}

__device__ __forceinline__ void attn0_unit(const Ptrs& p, LAS unsigned char* lds, int b, int h, int qb  ) {
    const int tid = otid(), wid = tid >> 6, lane = tid & 63, r32 = lane & 31, hi = lane >> 5, kvh = h / 3;
    const bf16* QKV = (const bf16*)(p.ws + WS_BIG);
    const size_t row0 = (size_t)b * TOK + qb * 256 + wid * 32;
    const bf16* Qw = QKV + (row0 + r32) * P0 + h * 64 + hi * 8;
    const bf16* const Kg[1] = {QKV + (size_t)b * TOK * P0 + 768 + kvh * 64};
    const bf16* Vg = QKV + (size_t)b * TOK * P0 + 1024 + kvh * 64;
    att::f32x16 o[2]; float l;
    att::attn_unit<1, 64>(Qw, Kg, Vg, P0, qb == 0 ? CTXL / 64 : TOK / 64, 0, lds, o, l);
    LAS float* li_l = (LAS float*)(lds + att::Cfg<1, 64>::SCR) + wid * 64;
    if (hi == 0) li_l[r32] = l; asm volatile("s_waitcnt lgkmcnt(0)" ::: "memory");
    int lofs = hi * 4 * D + r32; asm volatile("" : "+v"(lofs));
    bf16* Ob = (bf16*)(p.ws + WS_BUFB) + row0 * D + h * 64 + lofs;
#pragma unroll
    for (int r = 0; r < 16; ++r) { const float il = fast_rcp(li_l[att::crow(r, hi)]);
#pragma unroll
        for (int d0 = 0; d0 < 2; ++d0) Ob[((r & 3) + 8 * (r >> 2)) * D + d0 * 32] = (bf16)f2bf(o[d0][r] * il); }
    __syncthreads();
}
__device__ __forceinline__ void pool_chunk(const Ptrs& p, LAS unsigned char* lds, int chunk) {
    const int tid = otid();
    int rbase, n, t0;
    if (chunk < 256) { const int b = chunk / 32; rbase = b * TOK + CTXL; n = SEQ; t0 = (chunk % 32) * 64; }
    else { const int e = chunk - 256, b = e / 4; rbase = b * TOK; n = CTXL; t0 = (e % 4) * 64; }
    const bf16* U = (const bf16*)(p.ws + WS_BIG) + 1280;
    LAS unsigned short* ub = (LAS unsigned short*)lds;
    LAS float* pooled = (LAS float*)(lds + 80 * 512);
    for (int idx = tid; idx < 80 * 32; idx += NTHR) { const int row = idx >> 5, ch = (idx & 31) * 8, s = t0 - 8 + row;
        u32x4 v = {0u, 0u, 0u, 0u}; if (s >= 0 && s < n) v = *(const u32x4*)(U + (size_t)(rbase + s) * P0 + ch);
        *(LAS u32x4*)(ub + row * 256 + ch) = v; }
    __syncthreads();
    { const int c = tid & 255, g = c >> 6, w = 2 << g, half = tid >> 8;
        for (int tt = half * 32; tt < half * 32 + 32; ++tt) { const int t = t0 + tt, lo = max(t - w / 2, 0), hi = min(t + w - w / 2, n); float s = 0.f;
            for (int j = lo; j < hi; ++j) s += bf2f(ub[(j - t0 + 8) * 256 + c]);
            pooled[tt * 260 + c] = s / (float)(hi - lo) - bf2f(ub[(tt + 8) * 256 + c]); } }
    __syncthreads();
    { const int tb = tid >> 5, db = tid & 31, g = db >> 3, d0 = (db & 7) * 8; const float* W = p.ab_w_pool + (size_t)g * 4096 + d0;
        float acc[4][8];
#pragma unroll
        for (int i = 0; i < 4; ++i)
#pragma unroll
            for (int j = 0; j < 8; ++j) acc[i][j] = 0.f;
#pragma unroll 4
        for (int c = 0; c < 64; ++c) { const f32x4 w0 = *(const f32x4*)(W + c * 64), w1 = *(const f32x4*)(W + c * 64 + 4);
#pragma unroll
            for (int i = 0; i < 4; ++i) { const float pv = pooled[(tb * 4 + i) * 260 + g * 64 + c];
#pragma unroll
                for (int j = 0; j < 4; ++j) { acc[i][j] += pv * w0[j]; acc[i][4 + j] += pv * w1[j]; } } }
        const f32x4 s0 = *(const f32x4*)(p.ab_pool_scale + g * 64 + d0), s1 = *(const f32x4*)(p.ab_pool_scale + g * 64 + d0 + 4);
#pragma unroll
        for (int i = 0; i < 4; ++i) { u32x4 o; o.x = pk2(acc[i][0] * s0[0], acc[i][1] * s0[1]); o.y = pk2(acc[i][2] * s0[2], acc[i][3] * s0[3]); o.z = pk2(acc[i][4] * s1[0], acc[i][5] * s1[1]); o.w = pk2(acc[i][6] * s1[2], acc[i][7] * s1[3]);
            *(u32x4*)((bf16*)(p.ws + WS_BUFB) + (size_t)(rbase + t0 + tb * 4 + i) * D + 768 + g * 64 + d0) = o; } }
    __syncthreads();
}
__device__ __forceinline__ void phase_mix0(const Ptrs& p, LAS unsigned char* lds, int vcu) {
    const int x = vcu >> 5, c = vcu & 31;
    for (int i = 0; i < 3; ++i) { const int uidx = i * 32 + c, pair = x * 4 + uidx / 24, w = uidx % 24; attn0_unit(p, lds, pair >> 2, (pair & 3) * 3 + w / 8, 1 + (w & 7)); }
    if (vcu < 96) attn0_unit(p, lds, vcu / 12, vcu % 12, 0);
    for (int ch = vcu; ch < 288; ch += 256) pool_chunk(p, lds, ch);
}

__device__ __forceinline__ void attn1_unit(const Ptrs& p, LAS unsigned char* lds, int b, int h, int qb  , float lam) {
    typedef att::Cfg<2, 128> C;
    const int tid = otid(), wid = tid >> 6, lane = tid & 63, r32 = lane & 31, hi = lane >> 5, comp = wid >> 2, wq = wid & 3;
    const bf16* QKV = (const bf16*)(p.ws + WS_BIG);
    const size_t row0 = (size_t)b * TOK + CTXL + qb * 128 + wq * 32;
    const bf16* Qw = QKV + (row0 + r32) * P1 + (h * 2 + comp) * 64 + hi * 8;
    const bf16* const Kg[2] = {QKV + (size_t)b * TOK * P1 + 768 + (h * 2) * 64, QKV + (size_t)b * TOK * P1 + 768 + (h * 2 + 1) * 64};
    const bf16* Vg = QKV + (size_t)b * TOK * P1 + 1536 + h * 128;
    att::f32x16 o[4]; float l;
    att::attn_unit<2, 128>(Qw, Kg, Vg, P1, TOK / 64, comp, lds, o, l);
    LAS float* li_l = (LAS float*)(lds + C::SCR) + wid * 64;
    if (hi == 0) li_l[r32] = l; asm volatile("s_waitcnt lgkmcnt(0)" ::: "memory");
    LAS float* X = (LAS float*)(lds + C::TOTAL) + wq * 4096;
#pragma unroll
    for (int r = 0; r < 16; ++r) { const float il = fast_rcp(li_l[att::crow(r, hi)]);
#pragma unroll
        for (int d0 = 0; d0 < 4; ++d0) o[d0][r] *= il; }
    if (comp == 1) {
#pragma unroll
        for (int d0 = 0; d0 < 4; ++d0)
#pragma unroll
            for (int r = 0; r < 16; ++r) X[(d0 * 16 + r) * 64 + lane] = o[d0][r];
    }
    __syncthreads();
    if (comp == 0) {
        int lofs = hi * 4 * D + r32; asm volatile("" : "+v"(lofs));
        bf16* Ob = (bf16*)(p.ws + WS_BUFB) + row0 * D + h * 128 + lofs;
        float gsub[4];
#pragma unroll
        for (int d0 = 0; d0 < 4; ++d0) gsub[d0] = p.subln[d0 * 32 + r32];
#pragma unroll
        for (int r = 0; r < 16; ++r) { float ss = 0.f;
#pragma unroll
            for (int d0 = 0; d0 < 4; ++d0) { o[d0][r] -= lam * X[(d0 * 16 + r) * 64 + lane]; ss += o[d0][r] * o[d0][r]; }
            ss += __shfl_xor(ss, 1); ss += __shfl_xor(ss, 2); ss += __shfl_xor(ss, 4); ss += __shfl_xor(ss, 8); ss += __shfl_xor(ss, 16);
            const float rs = (1.f - LAM_INIT) / sqrtf(ss * (1.f / 128.f) + LN_EPS);
#pragma unroll
            for (int d0 = 0; d0 < 4; ++d0) Ob[((r & 3) + 8 * (r >> 2)) * D + d0 * 32] = (bf16)f2bf(o[d0][r] * rs * gsub[d0]); }
    }
    __syncthreads();
}
__device__ __forceinline__ void conv_chunk(const Ptrs& p, LAS unsigned char* lds, int chunk) {
    const int tid = otid(), wave = tid >> 6, lane = tid & 63, b = chunk / 32, t0 = (chunk % 32) * 64;
    const bf16* Z = (const bf16*)(p.ws + WS_BIG) + (size_t)(b * TOK + CTXL) * P1 + 2304;
    LAS unsigned* zb = (LAS unsigned*)lds;
    LAS float* cv = (LAS float*)(lds + 94 * 512);
    for (int idx = tid; idx < 94 * 32; idx += NTHR) { const int row = idx >> 5, ch = (idx & 31) * 8, s = t0 - 15 + row;
        u32x4 v = {0u, 0u, 0u, 0u}; if (s >= 0 && s < SEQ) v = *(const u32x4*)(Z + (size_t)s * P1 + ch);
        *(LAS u32x4*)((LAS unsigned short*)zb + row * 256 + ch) = v; }
    __syncthreads();
    { const int cp = tid & 127, tg = tid >> 7;
        unsigned zw[46];
#pragma unroll
        for (int i = 0; i < 46; ++i) zw[i] = zb[(tg * 16 + i) * 128 + cp];
        float a0[16], a1[16]; const float b0 = p.conv_b[2 * cp], b1 = p.conv_b[2 * cp + 1];
#pragma unroll
        for (int i = 0; i < 16; ++i) { a0[i] = b0; a1[i] = b1; }
#pragma unroll
        for (int j = 0; j < 31; ++j) { const f32x2 w = *(const f32x2*)(p.conv_w + j * 256 + 2 * cp);
#pragma unroll
            for (int i = 0; i < 16; ++i) { const unsigned z = zw[i + j]; a0[i] += __builtin_bit_cast(float, z << 16) * w.x; a1[i] += __builtin_bit_cast(float, z & 0xffff0000u) * w.y; } }
#pragma unroll
        for (int i = 0; i < 16; ++i) *(LAS f32x2*)(cv + (tg * 16 + i) * 256 + 2 * cp) = (f32x2){a0[i], a1[i]}; }
    __syncthreads();
    { const f32x4 g = *(const f32x4*)(p.conv_ln_g + 4 * lane), bb = *(const f32x4*)(p.conv_ln_b + 4 * lane);
        for (int i = 0; i < 8; ++i) { const int tt = wave * 8 + i; f32x4 v = *(LAS f32x4*)(cv + tt * 256 + 4 * lane);
            const float mean = wave_sum((v[0] + v[1]) + (v[2] + v[3])) * (1.f / 256.f); v = v - mean;
            const float rstd = 1.f / sqrtf(wave_sum((v[0] * v[0] + v[1] * v[1]) + (v[2] * v[2] + v[3] * v[3])) * (1.f / 256.f) + LN_EPS);
            v = v * rstd * g + bb; u32x2 o; o.x = pk2(silu_fast(v[0]), silu_fast(v[1])); o.y = pk2(silu_fast(v[2]), silu_fast(v[3]));
            *(u32x2*)((bf16*)(p.ws + WS_BUFB) + (size_t)(b * TOK + CTXL + t0 + tt) * D + 768 + 4 * lane) = o; } }
    __syncthreads();
}
__device__ __forceinline__ void phase_mix1(const Ptrs& p, LAS unsigned char* lds, int vcu) {
    LAS float* lamp = (LAS float*)(lds + LDS_BYTES - 64);
    if (otid() < 64) { const int l = otid(); const float a = wave_sum(p.lq1[l] * p.lk1[l]), c = wave_sum(p.lq2[l] * p.lk2[l]); if (l == 0) lamp[0] = expf(a) - expf(c) + LAM_INIT; }
    __syncthreads();
    const float lam = lamp[0];
    const int x = vcu >> 5, c = vcu & 31;
    for (int i = 0; i < 3; ++i) { const int uidx = i * 32 + c, grp = x * 6 + uidx / 16; attn1_unit(p, lds, grp / 6, grp % 6, uidx & 15, lam); }
    conv_chunk(p, lds, vcu);
}
#define XB_TMO      128
#define XB_XCNT(j)  (256  + 64 * (j))
#define XB_XSUB(j)  (1280 + 64 * (j))
#define XB_XGEN(j)  (2304 + 64 * (j))
#define XB_TOP      3328
#define XB_TOPGEN   3392
#define XCD_BAR_WORDS 3456
#define XB_SPIN_CAP (1u << 18)

__device__ __forceinline__ unsigned xb_ld(unsigned* p)              { return __hip_atomic_load(p, __ATOMIC_RELAXED, __HIP_MEMORY_SCOPE_AGENT); }
__device__ __forceinline__ unsigned xb_add(unsigned* p, unsigned v) { return __hip_atomic_fetch_add(p, v, __ATOMIC_RELAXED, __HIP_MEMORY_SCOPE_AGENT); }
__device__ __forceinline__ unsigned xb_xcc_id() { return (unsigned)__builtin_amdgcn_s_getreg((3 << 11) | 20) & 0xFu; }
#define XB_SPIN(cond, bar) do { unsigned _sp = 0; while (cond) { __builtin_amdgcn_s_sleep(1); \
    if ((++_sp & 255u) == 0u) { if (xb_ld(&(bar)[XB_TMO])) break; if (_sp > XB_SPIN_CAP) { atomicAdd(&(bar)[XB_TMO], 1u); break; } } } } while (0)

struct XcdBarrier {
    unsigned* bar; unsigned x;
    volatile LAS unsigned* st;
};

__device__ __forceinline__ XcdBarrier xcd_barrier_post(unsigned* bar, volatile LAS unsigned* st) {
    XcdBarrier b; b.bar = bar; b.x = xb_xcc_id(); b.st = st;
    if (otid() == 0) (void)xb_add(&bar[XB_XCNT(b.x)], 1u);
    return b;
}
__device__ __forceinline__ void xcd_barrier_complete(unsigned* bar, unsigned x, unsigned& nloc, unsigned& nx) {
    const unsigned G = gridDim.x * gridDim.y * gridDim.z;
    unsigned sum, cnt, mine, sp = 0u;
    for (;;) {
        sum = 0u; cnt = 0u; mine = 0u;
#pragma unroll
        for (unsigned j = 0; j < 16; ++j) { const unsigned c = xb_ld(&bar[XB_XCNT(j)]); sum += c; cnt += (c > 0u) ? 1u : 0u; mine = (j == x) ? c : mine; }
        if (sum == G) break;
        __builtin_amdgcn_s_sleep(1);
        if ((++sp & 255u) == 0u) { if (xb_ld(&bar[XB_TMO])) break; if (sp > XB_SPIN_CAP) { atomicAdd(&bar[XB_TMO], 1u); break; } }
    }
    nloc = mine > 0u ? mine : 1u; nx = cnt > 0u ? cnt : 1u;
}

__device__ __forceinline__ void xcd_barrier(const XcdBarrier& b) {
    asm volatile("s_waitcnt vmcnt(0)" ::: "memory");
    __syncthreads();
    if (otid() == 0) {
        unsigned* bar = b.bar;
        __builtin_amdgcn_s_waitcnt(0);
        unsigned nloc = b.st[0], nx = b.st[1];
        if (nloc == 0u) { xcd_barrier_complete(bar, b.x, nloc, nx); b.st[0] = nloc; b.st[1] = nx; }
        const unsigned old = xb_add(&bar[XB_XSUB(b.x)], 1u);
        const unsigned gen = old / nloc;
        if (old + 1u == (gen + 1u) * nloc) {
            __builtin_amdgcn_fence(__ATOMIC_RELEASE, "agent");
            asm volatile("s_waitcnt vmcnt(0)" ::: "memory");
            const unsigned og = xb_add(&bar[XB_TOP], 1u);
            const unsigned tg = og / nx;
            if (og + 1u == (tg + 1u) * nx) xb_add(&bar[XB_TOPGEN], 1u);
            else XB_SPIN(xb_ld(&bar[XB_TOPGEN]) == tg, bar);
            __builtin_amdgcn_fence(__ATOMIC_ACQUIRE, "agent");
            xb_add(&bar[XB_XGEN(b.x)], 1u);
            asm volatile("s_waitcnt vmcnt(0)" ::: "memory");
        } else {
            XB_SPIN(xb_ld(&bar[XB_XGEN(b.x)]) == gen, bar);
            __builtin_amdgcn_fence(__ATOMIC_ACQUIRE, "agent");
            asm volatile("s_waitcnt vmcnt(0)" ::: "memory");
        }
    }
    __syncthreads();
}

constexpr int NPHASE = 13;
struct MArgs { Ptrs p; int ph_lo, ph_hi; };
__global__ void __launch_bounds__(NTHR, 2) mega(MArgs a) {
    extern __shared__ __attribute__((aligned(16))) unsigned char lds_raw[];
    LAS unsigned char* lds = (LAS unsigned char*)lds_raw;
    const Ptrs& p = a.p;
    const int tid = otid(), lane = tid & 63, wave = __builtin_amdgcn_readfirstlane(tid >> 6);
    const int G = gridDim.x, bx = blockIdx.x, vcu = (G % 8 == 0) ? (bx % 8) * (G / 8) + bx / 8 : bx;
    const int lo = a.ph_lo, hi = a.ph_hi;
    volatile LAS unsigned* bst = (volatile LAS unsigned*)(lds + LDS_BYTES - 32);
    if (tid == 0) { bst[0] = 0u; bst[1] = 0u; }
    __syncthreads();
    const XcdBarrier xbar = xcd_barrier_post((unsigned*)(p.ws + WS_CTL) + 1024, bst);
#define IN(k) (lo <= (k) && (k) < hi)
#define SEAM(k) do { if (IN(k) && IN((k) + 1)) xcd_barrier(xbar); } while (0)
    const int NGW = G * NWAVES;
#ifdef PROBE_REP
    for (int rep = 0; rep < ((PROBE_REP) & 1) + 1; ++rep)
#endif
    if (IN(0)) { phase_prep(p, lds, vcu, G, tid, wave, lane); __syncthreads(); }
    SEAM(0);
    if (IN(1)) { const int t1 = otid(); phase_fold(p, lds, vcu, t1); for (int r = vcu * NWAVES + (t1 >> 6); r < R; r += NGW) row_pass(p, r, t1 & 63, 0, nullptr, nullptr, 0, 0); }
    SEAM(1);
    bf16* BUFA = (bf16*)(p.ws + WS_BUFA); bf16* BUFB = (bf16*)(p.ws + WS_BUFB); bf16* BIG = (bf16*)(p.ws + WS_BIG);
#define PHASE_STEP(S_) do { constexpr int s = (S_); constexpr int ph = s + 2, l = s / 5, k = s % 5; \
        if (IN(ph)) { \
            const int nM = l ? 64 : 72; \
            if (k == 0) { \
                pg8::Gemm g{BUFA, (const bf16*)(p.ws + (l ? WS_WIN1 : WS_WIN0)), 0, 0, D}; \
                TileSched S; if (l == 0) S.init(72, 6, G, bx, 0, 0); else S.init(64, 11, G, bx, 1, 48); \
                if (l == 0) { EpiIn<0> E{&p}; pg8::gemm_phase<EpiIn<0>, TileSched, true, true>(lds, g, S, E); } \
                if (l == 1) { EpiIn<1> E{&p}; pg8::gemm_phase<EpiIn<1>, TileSched, true, true>(lds, g, S, E); } \
            } else if (k == 1) { \
                if (l == 0) phase_mix0(p, lds, vcu); \
                if (l == 1) phase_mix1(p, lds, vcu); \
            } else if (k == 2 || k == 4) { \
                pg8::Gemm g{k == 2 ? BUFB : BIG, k == 2 ? (const bf16*)(p.ws + (l ? WS_WOUT1 : WS_WOUT0)) : (const bf16*)(p.ws + WS_WFOUT) + (size_t)l * D * FF, 0, 0, k == 2 ? D : FF}; \
                TileSched S; S.init(nM, 4, G, bx, l, 0); \
 \
                const int step = 2 * l + (k == 4); \
                EpiRes E{&p, l, k == 2 ? 2048 : 5120, step > 0, step - 1, step < 3 ? step : -1, step < 3 ? step : -1, \
                         step == 2 ? p.ln2_g : (step == 1 ? p.ln1_g : p.ln1_g + D), step == 2 ? p.ln2_b : (step == 1 ? p.ln1_b : p.ln1_b + D)}; \
                pg8::gemm_phase<EpiRes, TileSched, true, true>(lds, g, S, E); \
            } else { \
                pg8::Gemm g{BUFA, (const bf16*)(p.ws + WS_WFIN) + (size_t)l * 2 * FF * D, 0, 0, D}; \
                TileSched S; S.init(nM, 22, G, bx, l, 0); \
                EpiFfn E{&p, l ? 2 : 0, l ? 2 : 0}; \
                pg8::gemm_phase<EpiFfn, TileSched, true, true>(lds, g, S, E); \
            } \
        } \
        SEAM(ph); \
    } while (0)
    PHASE_STEP(0);
    PHASE_STEP(1);
    PHASE_STEP(2);
    PHASE_STEP(3);
    PHASE_STEP(4);
    PHASE_STEP(5);
    PHASE_STEP(6);
    PHASE_STEP(7);
    PHASE_STEP(8);
    PHASE_STEP(9);
#undef PHASE_STEP
    if (IN(12)) { const int t1 = otid();
        for (int i = vcu * NWAVES + (t1 >> 6); i < NB * SEQ; i += NGW) { const int r = (i / SEQ) * TOK + CTXL + i % SEQ; row_pass(p, r, t1 & 63, 1, p.ln2_g + D, p.ln2_b + D, 0, -1); } }
#undef IN
#undef SEAM
}

extern "C" void kernel_launch(void* const* d_in, const int* in_sizes, int n_in, void* d_out, int out_size, void* d_ws, size_t ws_size, hipStream_t stream) {
    if (n_in != 29 || in_sizes[0] != NB * SEQ * D || out_size != NB * SEQ * D || ws_size < WS_END) { fprintf(stderr, "kernel_launch: unexpected shapes (n_in %d, ws %zu)\n", n_in, ws_size); return; }
    static int grid = 0;
    if (grid == 0) {
        int dev = 0, cus = 0, per_cu = 0;
        (void)hipGetDevice(&dev); (void)hipDeviceGetAttribute(&cus, hipDeviceAttributeMultiprocessorCount, dev);
        if (hipFuncSetAttribute((const void*)mega, hipFuncAttributeMaxDynamicSharedMemorySize, LDS_BYTES) != hipSuccess) { fprintf(stderr, "kernel_launch: hipFuncSetAttribute failed\n"); grid = -1; return; }
        (void)hipOccupancyMaxActiveBlocksPerMultiprocessor(&per_cu, (const void*)mega, NTHR, LDS_BYTES);
        if (per_cu < 1) { fprintf(stderr, "kernel_launch: occupancy query says %d blocks per CU\n", per_cu); grid = -1; return; }
        grid = cus;
        fprintf(stderr, "kernel_launch: %d CUs, occupancy %d per CU, grid %d\n", cus, per_cu, grid);
    }
    if (grid < 0) return;
    MArgs a; memset(&a, 0, sizeof(a));
    const float** f = (const float**)&a.p;
    for (int i = 0; i < 29; ++i) f[i] = (const float*)d_in[i];
    a.p.out = (float*)d_out; a.p.ws = (unsigned char*)d_ws;
    {
        int ph = 0, e = NPHASE; a.ph_lo = ph; a.ph_hi = e;
        if (hipMemsetAsync((char*)d_ws + WS_CTL, 0, 64 * 1024, stream) != hipSuccess) fprintf(stderr, "kernel_launch: memset failed\n");
        void* args[] = {&a};
        hipError_t err = hipLaunchCooperativeKernel((const void*)mega, dim3(grid), dim3(NTHR), args, LDS_BYTES, stream);
        if (err != hipSuccess) fprintf(stderr, "kernel_launch: cooperative launch failed: %s (grid %d)\n", hipGetErrorString(err), grid);
    }
}
```

```cpp
#include <hip/hip_runtime.h>
#include <cstdio>
#include <cstdint>
#include <cmath>
#include <cstring>
#include <hip/hip_cooperative_groups.h>
namespace cg = cooperative_groups;

constexpr int D = 1024, NB = 8, SEQ = 2048, CTXL = 256, TOK = SEQ + CTXL, R = NB * TOK;
constexpr int FF = 2816, HD = 64;
constexpr int P0 = 1536;
constexpr int P1 = 2560;
constexpr int CIN1 = 2816;
constexpr float ALPHA = 1.4142135623730951f, LN_EPS = 1e-6f;
constexpr float QSCALE = 0.125f * 1.4426950408889634f;
constexpr float LAM_INIT = 0.35550906758f;
constexpr int MODW = 6 * D;

constexpr size_t MiB = 1u << 20;
constexpr size_t WS_CTL = 0, WS_MOD = 1 * MiB, WS_ROPE = WS_MOD + 2 * 9 * MODW * 4;
constexpr size_t WS_XC = 48 * MiB, WS_BUFA = 56 * MiB, WS_BUFB = 92 * MiB, WS_BIG = 128 * MiB;
constexpr size_t WS_STATS = 227 * MiB;
constexpr size_t WS_GVEC = WS_STATS + 3 * (size_t)R * 8;
constexpr size_t WS_GWBW = WS_GVEC + 3 * 9 * 1024 * 4;
constexpr int FOLD_N[3] = {2 * 2816, 2816, 2 * 2816};
constexpr size_t FOLD_BASE[3] = {0, 2 * 9 * 5632, 2 * 9 * 5632 + 2 * 9 * 2816};
constexpr size_t WS_END = 230 * MiB;
static_assert(WS_ROPE + 2 * 64 * 16 * 4 <= 2 * MiB, "ws map");

typedef unsigned short bf16;
typedef _Float16 h16x4 __attribute__((ext_vector_type(4)));
__device__ __forceinline__ unsigned f2bf(float f) { unsigned u = __builtin_bit_cast(unsigned, f); return (u + 0x7fffu + ((u >> 16) & 1u)) >> 16; }
__device__ __forceinline__ float bf2f(unsigned short h) { return __builtin_bit_cast(float, (unsigned)h << 16); }
__device__ __forceinline__ float silu_f(float x) { return x / (1.f + __expf(-x)); }
__device__ __forceinline__ float sigmoid_f(float x) { return 1.f / (1.f + __expf(-x)); }

struct Ptrs {
    const float *x, *c, *ctx, *c_ctx, *ab_w_in, *ab_q_gain, *ab_k_gain, *ab_w_pool, *ab_pool_scale, *ab_w_out,
        *cd_w_in, *lq1, *lk1, *lq2, *lk2, *subln, *conv_w, *conv_b, *conv_ln_g, *conv_ln_b, *cd_w_out,
        *ada_w, *ada_b, *ln1_g, *ln1_b, *ln2_g, *ln2_b, *ffn_w_in, *ffn_w_out;
    float* out; unsigned char* ws;
};
__device__ __forceinline__ float* res_row(const Ptrs& p, int r) {
    const int b = r / TOK, tp = r % TOK;
    return tp < CTXL ? (float*)(p.ws + WS_XC) + (size_t)(b * CTXL + tp) * D : p.out + (size_t)(b * SEQ + tp - CTXL) * D;
}
__device__ __forceinline__ const float* in_row(const Ptrs& p, int r) {
    const int b = r / TOK, tp = r % TOK;
    return tp < CTXL ? p.ctx + (size_t)(b * CTXL + tp) * D : p.x + (size_t)(b * SEQ + tp - CTXL) * D;
}
__device__ __forceinline__ const float* mod_vec(const Ptrs& p, int layer, int r) {
    const int b = r / TOK, tp = r % TOK;
    return (const float*)(p.ws + WS_MOD) + (size_t)(layer * 9 + (tp < CTXL ? 8 : b)) * MODW;
}

__device__ __forceinline__ float wave_sum(float v) {
#pragma unroll
    for (int o = 1; o < 64; o <<= 1) v += __shfl_xor(v, o);
    return v;
}
__device__ __forceinline__ void row_pass(const Ptrs& p, int r, int lane, int mode, const float* lng, const float* lnb, int hlayer, int hoff) {
    float4 v[4];
    if (mode == 0) { const float4* src = (const float4*)in_row(p, r);
#pragma unroll
        for (int j = 0; j < 4; ++j) v[j] = src[lane + 64 * j];
    } else {
        const h16x4* src = (const h16x4*)res_row(p, r);
#pragma unroll
        for (int j = 0; j < 4; ++j) { const h16x4 hv = src[lane + 64 * j]; v[j] = make_float4((float)hv[0], (float)hv[1], (float)hv[2], (float)hv[3]); }
    }
    if (mode == 1) {
        float s = 0.f;
#pragma unroll
        for (int j = 0; j < 4; ++j) s += (v[j].x + v[j].y) + (v[j].z + v[j].w);
        const float mean = wave_sum(s) * (1.f / D); float q = 0.f;
#pragma unroll
        for (int j = 0; j < 4; ++j) { v[j].x -= mean; v[j].y -= mean; v[j].z -= mean; v[j].w -= mean; q += (v[j].x * v[j].x + v[j].y * v[j].y) + (v[j].z * v[j].z + v[j].w * v[j].w); }
        const float rstd = 1.f / sqrtf(wave_sum(q) * (1.f / D) + LN_EPS);
        float4* dst = (float4*)res_row(p, r);
#pragma unroll
        for (int j = 0; j < 4; ++j) { const float4 g = ((const float4*)lng)[lane + 64 * j], b = ((const float4*)lnb)[lane + 64 * j];
            v[j].x = v[j].x * rstd * g.x + b.x; v[j].y = v[j].y * rstd * g.y + b.y; v[j].z = v[j].z * rstd * g.z + b.z; v[j].w = v[j].w * rstd * g.w + b.w; dst[lane + 64 * j] = v[j]; }
    }
    if (hoff >= 0) {
        const float* mv = mod_vec(p, hlayer, r); const float4* sh = (const float4*)(mv + hoff); const float4* sc = (const float4*)(mv + hoff + D);
        uint2* dst = (uint2*)((bf16*)(p.ws + WS_BUFA) + (size_t)r * D);
#pragma unroll
        for (int j = 0; j < 4; ++j) { const float4 a = sh[lane + 64 * j], s = sc[lane + 64 * j];
            const float h0 = v[j].x * (1.f + s.x) + a.x, h1 = v[j].y * (1.f + s.y) + a.y, h2 = v[j].z * (1.f + s.z) + a.z, h3 = v[j].w * (1.f + s.w) + a.w;
            dst[lane + 64 * j] = make_uint2(f2bf(h0) | (f2bf(h1) << 16), f2bf(h2) | (f2bf(h3) << 16)); }
    }
}
__device__ __forceinline__ int otid() { int t = threadIdx.x; asm volatile("" : "+v"(t)); return t; }
namespace pg8 {
#define PG8_LAS __attribute__((address_space(3)))
typedef unsigned short bf16_t;
typedef short bf16x8 __attribute__((ext_vector_type(8)));
typedef float f32x4 __attribute__((ext_vector_type(4)));
typedef unsigned u32x4 __attribute__((ext_vector_type(4)));
constexpr int BM = 256, BK = 64, HALF = 128, HTB = HALF * BK * 2  , STAGE_BYTES = 8 * HTB, NXCD = 8, WGM = 8;

__host__ __device__ __forceinline__ int lds_byte(int r, int c) { const int st = (r >> 4) * 2 + (c >> 5), rr = r & 15, cc = c & 31, ob = rr * 64 + cc * 2; return st * 1024 + (ob ^ (((ob >> 9) & 1) << 5)); }
__host__ __device__ __forceinline__ void stage_rc(int b, int& R, int& C) { const int st = b / 1024, sb = b % 1024, swz = sb ^ (((sb >> 9) & 1) << 5); R = (st >> 1) * 16 + swz / 64; C = (st & 1) * 32 + (swz % 64) / 2; }
__host__ __device__ __forceinline__ int perm32(int rho) { const int n = rho >> 4, i = rho & 15; return 8 * (i >> 2) + 4 * n + (i & 3); }

struct Unit { int pm, pn; };
struct Gemm { const bf16_t* A; const bf16_t* Bt; int M, N, K; };

__device__ __forceinline__ unsigned cvt_pk_bf16(float lo, float hi) { unsigned r; asm volatile("v_cvt_pk_bf16_f32 %0, %1, %2" : "=v"(r) : "v"(lo), "v"(hi)); return r; }
typedef float f32x2 __attribute__((ext_vector_type(2)));

template <class Epi, class Sched, bool ALIGN_EPI = false, bool SP2 = false>
__device__ __forceinline__ void gemm_phase(PG8_LAS unsigned char* lds, const Gemm g, const Sched& S, const Epi& E) {
    const int tid = otid(), wid = __builtin_amdgcn_readfirstlane(tid >> 6), lane = tid & 63, wr = wid >> 2, wc = wid & 3, fr = lane & 15, fq = lane >> 4;
    const int K = g.K, nt = K / BK;
    unsigned voffA[2], voffB[2];
#pragma unroll
    for (int i = 0; i < 2; ++i) { int R, C; stage_rc(tid * 16 + i * 8192, R, C); const int Rb = Epi::PERM ? ((R & ~31) + perm32(R & 31)) : R;
        voffA[i] = (unsigned)(R * K + C) * 2u; voffB[i] = (unsigned)(Rb * K + C) * 2u; }
    const size_t kstep = (size_t)(BK * 2);
    const size_t hstep = (size_t)HALF * K * 2;
    const size_t tstep = 2 * hstep;
    const unsigned ldsw = (unsigned)wid * 1024u;
    const int aoff = lds_byte(wr * 64 + fr, fq * 8), boff = lds_byte(wc * 32 + fr, fq * 8);
#define PG8_SA(b, h) (((b) * 2 + (h)) * HTB)
#define PG8_SB(b, h) ((4 + (b) * 2 + (h)) * HTB)
#define PG8_STAGE(bufoff, gbase, voff) do { _Pragma("unroll") for (int _i = 0; _i < 2; ++_i) \
        __builtin_amdgcn_global_load_lds((const unsigned*)((const char*)(gbase) + (voff)[_i]), (PG8_LAS unsigned*)(lds + (bufoff) + ldsw + _i * 8192), 16, 0, 0); } while (0)
#define PG8_LDA(dst, b, h) do { _Pragma("unroll") for (int m = 0; m < 4; ++m) _Pragma("unroll") for (int k = 0; k < 2; ++k) dst[m][k] = *(const PG8_LAS bf16x8*)(lds + PG8_SA(b, h) + aoff + m * 2048 + k * 1024); } while (0)
#define PG8_LDB(dst, b, h) do { _Pragma("unroll") for (int n = 0; n < 2; ++n) _Pragma("unroll") for (int k = 0; k < 2; ++k) dst[n][k] = *(const PG8_LAS bf16x8*)(lds + PG8_SB(b, h) + boff + n * 2048 + k * 1024); } while (0)
#define PG8_MMA(ai, bj, At, Bt) do { __builtin_amdgcn_s_setprio(1); _Pragma("unroll") for (int m = 0; m < 4; ++m) _Pragma("unroll") for (int n = 0; n < 2; ++n) _Pragma("unroll") for (int k = 0; k < 2; ++k) \
        acc[ai][bj][m][n] = __builtin_amdgcn_mfma_f32_16x16x32_bf16(Bt[n][k], At[m][k], acc[ai][bj][m][n], 0, 0, 0); __builtin_amdgcn_s_setprio(0); } while (0)
#define PG8_WAIT_V(n) asm volatile("s_waitcnt vmcnt(" #n ")" ::: "memory")
#define PG8_WAIT_L(n) asm volatile("s_waitcnt lgkmcnt(" #n ")" ::: "memory")
#define PG8_BAR __builtin_amdgcn_s_barrier()
#define PG8_SCHED __builtin_amdgcn_sched_barrier(0)
    Unit cur, nxt; int ui = 0;
    if (!S.next(0, cur)) return;
    f32x4 acc[2][2][4][2];
#pragma unroll
    for (int a = 0; a < 2; ++a)
#pragma unroll
        for (int b = 0; b < 2; ++b)
#pragma unroll
            for (int m = 0; m < 4; ++m)
#pragma unroll
                for (int n = 0; n < 2; ++n) acc[a][b][m][n] = (f32x4){0.f, 0.f, 0.f, 0.f};
    bf16x8 At[4][2], B0[2][2], B1[2][2];
    const char* cA = (const char*)g.A + (size_t)cur.pm * tstep; const char* cB = (const char*)g.Bt + (size_t)cur.pn * tstep;
    S.a_ready(cur);
    if constexpr (SP2) {
        PG8_STAGE(PG8_SB(0, 0), cB, voffB); PG8_STAGE(PG8_SB(0, 1), cB + hstep, voffB); PG8_STAGE(PG8_SA(0, 0), cA, voffA); PG8_STAGE(PG8_SA(0, 1), cA + hstep, voffA);
        if (wr == 1) PG8_BAR;
        PG8_WAIT_V(2); PG8_BAR;
        PG8_STAGE(PG8_SB(1, 0), cB + kstep, voffB); PG8_STAGE(PG8_SA(1, 0), cA + kstep, voffA); PG8_STAGE(PG8_SB(1, 1), cB + hstep + kstep, voffB);
        PG8_WAIT_V(6); PG8_BAR;
    } else {
        PG8_STAGE(PG8_SB(0, 0), cB, voffB); PG8_STAGE(PG8_SA(0, 0), cA, voffA); PG8_STAGE(PG8_SB(0, 1), cB + hstep, voffB); PG8_STAGE(PG8_SA(0, 1), cA + hstep, voffA);
        if (wr == 1) PG8_BAR;
        PG8_WAIT_V(4); PG8_BAR;
        PG8_STAGE(PG8_SB(1, 0), cB + kstep, voffB); PG8_STAGE(PG8_SA(1, 0), cA + kstep, voffA); PG8_STAGE(PG8_SB(1, 1), cB + hstep + kstep, voffB);
        PG8_WAIT_V(6); PG8_BAR;
    }
    for (;;) {
        const bool has_next = S.next(ui + 1, nxt);
        const char* nA = has_next ? (const char*)g.A + (size_t)nxt.pm * tstep : cA; const char* nB = has_next ? (const char*)g.Bt + (size_t)nxt.pn * tstep : cB;
        for (int t = 0; t < nt; t += 2) {
            const bool last = (t == nt - 2);
            const char* a1 = cA + (size_t)(t + 1) * kstep;
            const char* a2 = last ? nA : cA + (size_t)(t + 2) * kstep; const char* b2 = last ? nB : cB + (size_t)(t + 2) * kstep;
            const char* a3 = a2 + kstep; const char* b3 = b2 + kstep;
            if (last && has_next) S.a_ready(nxt);
            if constexpr (SP2) {
            PG8_LDB(B0, 0, 0); PG8_LDB(B1, 0, 1); PG8_SCHED; PG8_LDA(At, 0, 0); PG8_STAGE(PG8_SA(1, 1), a1 + hstep, voffA);
            PG8_WAIT_V(8); PG8_WAIT_L(0); PG8_BAR; PG8_MMA(0, 0, At, B0); PG8_MMA(0, 1, At, B1); PG8_BAR; PG8_SCHED;
            PG8_LDA(At, 0, 1); PG8_STAGE(PG8_SB(0, 0), b2, voffB); PG8_STAGE(PG8_SB(0, 1), b2 + hstep, voffB); PG8_STAGE(PG8_SA(0, 0), a2, voffA);
            PG8_WAIT_V(8); PG8_WAIT_L(0); PG8_BAR; PG8_MMA(1, 0, At, B0); PG8_MMA(1, 1, At, B1); PG8_BAR; PG8_SCHED;
            PG8_LDB(B0, 1, 0); PG8_LDB(B1, 1, 1); PG8_SCHED; PG8_LDA(At, 1, 0); PG8_STAGE(PG8_SA(0, 1), a2 + hstep, voffA);
            PG8_WAIT_V(8); PG8_WAIT_L(0); PG8_BAR; PG8_MMA(0, 0, At, B0); PG8_MMA(0, 1, At, B1); PG8_BAR; PG8_SCHED;
            PG8_LDA(At, 1, 1); PG8_STAGE(PG8_SB(1, 0), b3, voffB); PG8_STAGE(PG8_SB(1, 1), b3 + hstep, voffB); PG8_STAGE(PG8_SA(1, 0), a3, voffA);
            PG8_WAIT_V(8); PG8_WAIT_L(0); PG8_BAR; PG8_MMA(1, 0, At, B0); PG8_MMA(1, 1, At, B1); PG8_BAR; PG8_SCHED;
            } else {
            PG8_LDB(B0, 0, 0); PG8_SCHED; PG8_LDA(At, 0, 0); PG8_STAGE(PG8_SA(1, 1), a1 + hstep, voffA);
            PG8_WAIT_L(8); PG8_BAR; PG8_WAIT_L(0); PG8_MMA(0, 0, At, B0); PG8_BAR; PG8_SCHED;
            PG8_LDB(B1, 0, 1); PG8_STAGE(PG8_SB(0, 0), b2, voffB);
            PG8_BAR; PG8_WAIT_L(0); PG8_MMA(0, 1, At, B1); PG8_BAR;
            PG8_LDA(At, 0, 1); PG8_STAGE(PG8_SA(0, 0), a2, voffA);
            PG8_BAR; PG8_WAIT_L(0); PG8_MMA(1, 0, At, B0); PG8_BAR; PG8_SCHED;
            PG8_STAGE(PG8_SB(0, 1), b2 + hstep, voffB);
            PG8_WAIT_V(6); PG8_BAR; PG8_MMA(1, 1, At, B1); PG8_BAR;
            PG8_LDB(B0, 1, 0); PG8_SCHED; PG8_LDA(At, 1, 0); PG8_STAGE(PG8_SA(0, 1), a2 + hstep, voffA);
            PG8_WAIT_L(8); PG8_BAR; PG8_WAIT_L(0); PG8_MMA(0, 0, At, B0); PG8_BAR; PG8_SCHED;
            PG8_LDB(B1, 1, 1); PG8_STAGE(PG8_SB(1, 0), b3, voffB);
            PG8_BAR; PG8_WAIT_L(0); PG8_MMA(0, 1, At, B1); PG8_BAR;
            PG8_LDA(At, 1, 1); PG8_STAGE(PG8_SA(1, 0), a3, voffA);
            PG8_BAR; PG8_WAIT_L(0); PG8_MMA(1, 0, At, B0); PG8_BAR; PG8_SCHED;
            PG8_STAGE(PG8_SB(1, 1), b3 + hstep, voffB);
            PG8_WAIT_V(6); PG8_BAR; PG8_MMA(1, 1, At, B1); PG8_BAR;
            }
        }
        if constexpr (ALIGN_EPI) { if (wr == 0) PG8_BAR; }
        if constexpr (!Epi::AFTER_DRAIN) { E(acc, cur, wr, wc, fr, fq); S.done(cur); }
        if (!has_next) break;
#pragma unroll
        for (int a = 0; a < 2; ++a)
#pragma unroll
            for (int b = 0; b < 2; ++b)
#pragma unroll
                for (int m = 0; m < 4; ++m)
#pragma unroll
                    for (int n = 0; n < 2; ++n) acc[a][b][m][n] = (f32x4){0.f, 0.f, 0.f, 0.f};
        cur = nxt; cA = nA; cB = nB; ++ui;
        if constexpr (ALIGN_EPI) { if (wr == 1) PG8_BAR; }
    }
    PG8_WAIT_V(0);
    if constexpr (!ALIGN_EPI) { if (wr == 0) PG8_BAR; }
    PG8_BAR;
    if constexpr (Epi::AFTER_DRAIN) { E.fused(acc, cur, wr, wc, fr, fq, lds, wid, lane); S.done(cur); }
#undef PG8_SA
#undef PG8_SB
#undef PG8_STAGE
#undef PG8_LDA
#undef PG8_LDB
#undef PG8_MMA
#undef PG8_WAIT_V
#undef PG8_WAIT_L
#undef PG8_BAR
#undef PG8_SCHED
}
}

#define LAS __attribute__((address_space(3)))
typedef float f32x4 __attribute__((ext_vector_type(4)));
typedef unsigned u32x4 __attribute__((ext_vector_type(4)));
typedef unsigned u32x2 __attribute__((ext_vector_type(2)));
typedef float f32x2 __attribute__((ext_vector_type(2)));
constexpr int NWAVES = 8, NTHR = 512;
constexpr size_t WS_WIN0 = 2 * MiB, WS_WOUT0 = 5 * MiB, WS_WIN1 = 7 * MiB, WS_WOUT1 = 12 * MiB + 512 * 1024, WS_WFIN = 14 * MiB + 512 * 1024, WS_WFOUT = 36 * MiB + 512 * 1024;
static_assert(WS_WFOUT + 2 * (size_t)D * FF * 2 <= WS_XC, "weights fit below XC");
constexpr int LDS_BYTES = 147456;

__device__ __forceinline__ float fast_rcp(float x) { return __builtin_amdgcn_rcpf(x); }
__device__ __forceinline__ float silu_fast(float x) { return x * fast_rcp(1.f + __builtin_amdgcn_exp2f(-1.4426950408889634f * x)); }
__device__ __forceinline__ float sigmoid_fast(float x) { return fast_rcp(1.f + __builtin_amdgcn_exp2f(-1.4426950408889634f * x)); }

__device__ __forceinline__ int srccol(int kind, int n0) {
    const int t = n0 >> 8, p = n0 & 255;
    if (kind == 0) return n0;
    if (kind == 1 || (kind == 2 && n0 < 2304)) return t * 256 + 64 * ((p >> 5) & 3) + 32 * (p >> 7);
    if (kind == 2) return 2304 + (p >> 7) * 256 + 128 * (t - 9) + (p & 127);
    return (p >> 7) * FF + 128 * t + (p & 127);
}
__device__ __forceinline__ unsigned pk2(float lo, float hi) { return f2bf(lo) | (f2bf(hi) << 16); }
__device__ __forceinline__ void transpose_item(const float* W, int K, int N, bf16* WT, int kind, LAS float* scr, int item, int lane) {
    const int nblk = N / 64, kb = item / nblk, nb = item % nblk, k0 = 64 * kb, n0 = 64 * nb, cidx = lane & 15, rsub = lane >> 4;
    const float* src = W + (size_t)(k0 + rsub) * N + srccol(kind, n0 + 32 * (cidx >> 3)) + 4 * (cidx & 7);
    f32x4 v[16];
#pragma unroll
    for (int i = 0; i < 16; ++i) v[i] = *(const f32x4*)(src + (size_t)(4 * i) * N);
#pragma unroll
    for (int i = 0; i < 16; ++i) { LAS float* d = scr + (4 * i + rsub) * 65 + 4 * cidx; d[0] = v[i][0]; d[1] = v[i][1]; d[2] = v[i][2]; d[3] = v[i][3]; }
    asm volatile("s_waitcnt lgkmcnt(0)" ::: "memory");
    const int kc = lane & 7;
#pragma unroll
    for (int j = 0; j < 8; ++j) { const int n = 8 * j + (lane >> 3); const LAS float* sp = scr + (8 * kc) * 65 + n;
        u32x4 o; o.x = pk2(sp[0 * 65], sp[1 * 65]); o.y = pk2(sp[2 * 65], sp[3 * 65]); o.z = pk2(sp[4 * 65], sp[5 * 65]); o.w = pk2(sp[6 * 65], sp[7 * 65]);
        *(u32x4*)(WT + (size_t)(n0 + n) * K + k0 + 8 * kc) = o; }
    asm volatile("s_waitcnt lgkmcnt(0)" ::: "memory");
}
__device__ __forceinline__ void vecmat64(const float* W, int ldw, int c0, LAS const float* T, LAS float* part, float* out, int ldo, const float* bias, int tid) {
    const int wave = tid >> 6, lane = tid & 63, c4 = lane & 15, kg = (lane >> 4) + 4 * wave;
    const float* Wp = W + (size_t)(kg * 32) * ldw + c0 + 4 * c4;
    f32x4 acc[9];
#pragma unroll
    for (int v = 0; v < 9; ++v) acc[v] = (f32x4){0.f, 0.f, 0.f, 0.f};
#pragma unroll 8
    for (int kk = 0; kk < 32; ++kk) { const f32x4 w = *(const f32x4*)(Wp + (size_t)kk * ldw);
#pragma unroll
        for (int v = 0; v < 9; ++v) acc[v] += w * T[v * 1024 + kg * 32 + kk]; }
#pragma unroll
    for (int v = 0; v < 9; ++v) {
#pragma unroll
        for (int i = 0; i < 4; ++i) { float x = acc[v][i]; x += __shfl_xor(x, 16); x += __shfl_xor(x, 32); acc[v][i] = x; }
        if (lane < 16) *(LAS f32x4*)(part + (wave * 9 + v) * 64 + 4 * c4) = acc[v]; }
    __syncthreads();
    for (int e = tid; e < 9 * 64; e += NTHR) { const int v = e >> 6, c = e & 63; float sum = 0.f;
#pragma unroll
        for (int w = 0; w < 8; ++w) sum += part[(w * 9 + v) * 64 + c];
        out[(size_t)v * ldo + c0 + c] = sum + (bias ? bias[c0 + c] : 0.f); }
    __syncthreads();
}
__device__ __forceinline__ void phase_prep(const Ptrs& p, LAS unsigned char* lds, int vcu, int G, int tid, int wave, int lane) {
    {
        LAS float* scr = (LAS float*)(lds + wave * 16640);
        const int gw = vcu * NWAVES + wave, NGW = G * NWAVES;
        constexpr int I0 = 16 * (P0 / 64), I1 = 16 * (D / 64), I2 = 16 * (CIN1 / 64), I3 = I1, I4 = 16 * (2 * FF / 64), I5 = (FF / 64) * (D / 64);
        constexpr int NITEMS = I0 + I1 + I2 + I3 + 2 * I4 + 2 * I5;
        for (int it = gw; it < NITEMS; it += NGW) {
            int r = it;
            if (r < I0) { transpose_item(p.ab_w_in, D, P0, (bf16*)(p.ws + WS_WIN0), 1, scr, r, lane); continue; } r -= I0;
            if (r < I1) { transpose_item(p.ab_w_out, D, D, (bf16*)(p.ws + WS_WOUT0), 0, scr, r, lane); continue; } r -= I1;
            if (r < I2) { transpose_item(p.cd_w_in, D, CIN1, (bf16*)(p.ws + WS_WIN1), 2, scr, r, lane); continue; } r -= I2;
            if (r < I3) { transpose_item(p.cd_w_out, D, D, (bf16*)(p.ws + WS_WOUT1), 0, scr, r, lane); continue; } r -= I3;
            if (r < 2 * I4) { const int l = r / I4; transpose_item(p.ffn_w_in + (size_t)l * D * 2 * FF, D, 2 * FF, (bf16*)(p.ws + WS_WFIN) + (size_t)l * 2 * FF * D, 3, scr, r % I4, lane); continue; } r -= 2 * I4;
            { const int l = r / I5; transpose_item(p.ffn_w_out + (size_t)l * FF * D, FF, D, (bf16*)(p.ws + WS_WFOUT) + (size_t)l * D * FF, 0, scr, r % I5, lane); }
        }
    }
    __syncthreads();
    if (vcu < 192) {
        LAS float* T = (LAS float*)lds; LAS float* part = (LAS float*)(lds + 9 * 1024 * 4);
        for (int e = tid; e < 9 * 1024; e += NTHR) { const int v = e >> 10, k = e & 1023; T[e] = silu_f(v < 8 ? p.c[v * D + k] : p.c_ctx[k]); }
        __syncthreads();
        const int l = vcu / 96, cb = (vcu % 96) * 64;
        vecmat64(p.ada_w + (size_t)l * D * MODW, MODW, cb, T, part, (float*)(p.ws + WS_MOD) + (size_t)l * 9 * MODW, MODW, p.ada_b + l * MODW, tid);
    } else {
        f32x4* st = (f32x4*)(p.ws + WS_STATS);
        for (int e = (vcu - 192) * NTHR + tid; e < 3 * R * 2 / 4; e += (G - 192) * NTHR) st[e] = (f32x4){0.f, 0.f, 0.f, 0.f};
        if (vcu == 192) for (int e = tid; e < 1024; e += NTHR) { const int pos = e / 16, i = e % 16; const double fr = pow(10000.0, -(2.0 * i) / 32.0), ang = (double)pos * fr;
            float* rope = (float*)(p.ws + WS_ROPE); rope[e] = (float)cos(ang); rope[1024 + e] = (float)sin(ang); }
    }
}
__device__ __forceinline__ void phase_fold(const Ptrs& p, LAS unsigned char* lds, int vcu, int tid) {
    if (vcu >= 220) return;
    const int f = vcu < 88 ? 0 : (vcu < 132 ? 1 : 2), q = vcu - (f == 0 ? 0 : (f == 1 ? 88 : 132)), wave = tid >> 6, lane = tid & 63;
    const float* lng = f == 0 ? p.ln1_g : (f == 1 ? p.ln2_g : p.ln1_g + D); const float* lnb = f == 0 ? p.ln1_b : (f == 1 ? p.ln2_b : p.ln1_b + D);
    const int ml = f == 0 ? 0 : 1, sc_off = f == 1 ? 1024 : 4096, sh_off = f == 1 ? 0 : 3072, N = f == 1 ? CIN1 : 2 * FF, kind = f == 1 ? 2 : 3;
    const bf16* Wt = f == 0 ? (const bf16*)(p.ws + WS_WFIN) : (f == 1 ? (const bf16*)(p.ws + WS_WIN1) : (const bf16*)(p.ws + WS_WFIN) + (size_t)2 * FF * D);
    LAS float* TG = (LAS float*)lds; LAS float* TB = (LAS float*)(lds + 9 * 1024 * 4);
    const float* mod = (const float*)(p.ws + WS_MOD) + (size_t)ml * 9 * MODW;
    for (int e = tid; e < 9 * 1024; e += NTHR) { const int v = e >> 10, k = e & 1023; const float sc = mod[v * MODW + sc_off + k], sh = mod[v * MODW + sh_off + k], g = lng[k] * (1.f + sc);
        TG[e] = g; TB[e] = lnb[k] * (1.f + sc) + sh;
        if (q == 0) ((float*)(p.ws + WS_GVEC))[f * 9 * 1024 + e] = g; }
    __syncthreads();
    float* out = (float*)(p.ws + WS_GWBW) + (f == 0 ? 0 : (f == 1 ? 2 * 9 * 5632 : 2 * 9 * 5632 + 2 * 9 * 2816));
    for (int pr = 0; pr < 4; ++pr) {
        const int na = q * 64 + wave * 8 + 2 * pr;
        float wa[16], wb[16];
        { const u32x4 a0 = *(const u32x4*)(Wt + (size_t)na * D + 8 * lane), a1 = *(const u32x4*)(Wt + (size_t)na * D + 512 + 8 * lane);
          const u32x4 b0 = *(const u32x4*)(Wt + (size_t)(na + 1) * D + 8 * lane), b1 = *(const u32x4*)(Wt + (size_t)(na + 1) * D + 512 + 8 * lane);
#pragma unroll
          for (int i = 0; i < 4; ++i) { wa[2 * i] = __builtin_bit_cast(float, a0[i] << 16); wa[2 * i + 1] = __builtin_bit_cast(float, a0[i] & 0xffff0000u); wa[8 + 2 * i] = __builtin_bit_cast(float, a1[i] << 16); wa[8 + 2 * i + 1] = __builtin_bit_cast(float, a1[i] & 0xffff0000u);
              wb[2 * i] = __builtin_bit_cast(float, b0[i] << 16); wb[2 * i + 1] = __builtin_bit_cast(float, b0[i] & 0xffff0000u); wb[8 + 2 * i] = __builtin_bit_cast(float, b1[i] << 16); wb[8 + 2 * i + 1] = __builtin_bit_cast(float, b1[i] & 0xffff0000u); } }
        const int ca = srccol(kind, na & ~31) + (na & 31), cb = ca + 1;
        int lo8 = 8 * lane; asm volatile("" : "+v"(lo8));
#pragma unroll
        for (int v = 0; v < 9; ++v) {
            float ga = 0.f, gb = 0.f, ba = 0.f, bb = 0.f;
#pragma unroll
            for (int h = 0; h < 2; ++h) { const f32x4 g0 = *(LAS const f32x4*)(TG + v * 1024 + h * 512 + lo8), g1 = *(LAS const f32x4*)(TG + v * 1024 + h * 512 + lo8 + 4);
                const f32x4 t0 = *(LAS const f32x4*)(TB + v * 1024 + h * 512 + lo8), t1 = *(LAS const f32x4*)(TB + v * 1024 + h * 512 + lo8 + 4);
#pragma unroll
                for (int i = 0; i < 4; ++i) { ga += wa[8 * h + i] * g0[i] + wa[8 * h + 4 + i] * g1[i]; gb += wb[8 * h + i] * g0[i] + wb[8 * h + 4 + i] * g1[i];
                    ba += wa[8 * h + i] * t0[i] + wa[8 * h + 4 + i] * t1[i]; bb += wb[8 * h + i] * t0[i] + wb[8 * h + 4 + i] * t1[i]; } }
            ga = wave_sum(ga); gb = wave_sum(gb); ba = wave_sum(ba); bb = wave_sum(bb);
            if (lane == 0) { out[(size_t)v * N + ca] = ga; out[(size_t)v * N + cb] = gb; out[(size_t)(9 + v) * N + ca] = ba; out[(size_t)(9 + v) * N + cb] = bb; }
        }
    }
}

struct TileSched {
    int nM, nN, nwg, G, c, mode, extra;
    __device__ __forceinline__ void init(int nM_, int nN_, int G_, int c_, int mode_, int extra_) { nM = nM_; nN = nN_; nwg = nM * nN; G = G_; c = c_; mode = mode_; extra = extra_; }
    __device__ __forceinline__ bool next(int i, pg8::Unit& u) const {
        const long L = (long)i * G + c; if (L >= nwg + extra) return false;
        if (L >= nwg) { const int e = (int)L - nwg; u.pm = (e / 6) * 9; u.pn = 3 + e % 6; return true; }
        int wgid = (int)L; { const int q = nwg / 8, r = nwg % 8, xcd = wgid % 8, off = wgid / 8; wgid = (xcd < r ? xcd * (q + 1) : r * (q + 1) + (xcd - r) * q) + off; }
        const int nig = 8 * nN, gid = wgid / nig, fm = gid * 8, gsz = (nM - fm) < 8 ? (nM - fm) : 8;
        const int lp = fm + ((wgid % nig) % gsz); u.pn = (wgid % nig) / gsz;
        u.pm = mode ? (lp >> 3) * 9 + 1 + (lp & 7) : lp; return true;
    }
    __device__ __forceinline__ void a_ready(const pg8::Unit&) const {}
    __device__ __forceinline__ void done(const pg8::Unit&) const {}
};
__device__ __forceinline__ void row_norm(const float* stats, size_t r, float& mu, float& rstd) {
    const f32x2 sv = *(const f32x2*)(stats + 2 * r); mu = sv.x * (1.f / D); rstd = 1.f / sqrtf(sv.y * (1.f / D) - mu * mu + LN_EPS);
}
template <int LAYER> struct EpiIn {
    static constexpr bool PERM = false, AFTER_DRAIN = false;
    const Ptrs* p;
    __device__ __forceinline__ void operator()(const f32x4 (&acc)[2][2][4][2], const pg8::Unit& u, int wr, int wc, int fr, int fq) const {
        constexpr int layer = LAYER;
        const int pn = u.pn, kind = layer == 0 ? (pn < 3 ? 0 : (pn == 3 ? 1 : 2)) : (pn < 3 ? 0 : (pn < 6 ? 1 : (pn < 9 ? 2 : 3)));
        const int pitch = layer == 0 ? P0 : P1, jrow = u.pm % 9; const bool lat = jrow != 0;
        bf16* O = (bf16*)(p->ws + WS_BIG);
        const float* rope = (const float*)(p->ws + WS_ROPE);
        int lrow = wr * 64 + fr; asm volatile("" : "+v"(lrow));
        const int cnat0 = kind < 3 ? pn * 256 + wc * 64 + 4 * fq : 2304 + (pn - 9) * 128 + wc * 32 + 4 * fq, cbj = kind < 3 ? 32 : 256;
        f32x4 gn[2][2], gw[2][2], bw[2][2];
        const float* gwb = (const float*)(p->ws + WS_GWBW) + FOLD_BASE[1] + (size_t)(lat ? u.pm / 9 : 8) * CIN1;
#pragma unroll
        for (int bj = 0; bj < 2; ++bj)
#pragma unroll
            for (int n = 0; n < 2; ++n) {
                gn[bj][n] = (layer == 0 && kind < 2) ? *(const f32x4*)((kind == 0 ? p->ab_q_gain : p->ab_k_gain) + bj * 32 + n * 16 + 4 * fq) : (f32x4){1.f, 1.f, 1.f, 1.f};
                if (layer == 1) { gw[bj][n] = *(const f32x4*)(gwb + cnat0 + bj * cbj + n * 16); bw[bj][n] = *(const f32x4*)(gwb + 9 * CIN1 + cnat0 + bj * cbj + n * 16); } }
#pragma unroll
        for (int ai = 0; ai < 2; ++ai)
#pragma unroll
            for (int m = 0; m < 4; ++m) {
                const int rr = ai * 128 + m * 16 + lrow; const size_t r = (size_t)u.pm * 256 + rr;
                f32x4 a[2][2];
#pragma unroll
                for (int bj = 0; bj < 2; ++bj)
#pragma unroll
                    for (int n = 0; n < 2; ++n) a[bj][n] = acc[ai][bj][m][n];
                if (layer == 1) { float mu, rstd; row_norm((const float*)(p->ws + WS_STATS) + (size_t)1 * R * 2, r, mu, rstd); const float mr = mu * rstd;
#pragma unroll
                    for (int bj = 0; bj < 2; ++bj)
#pragma unroll
                        for (int n = 0; n < 2; ++n) a[bj][n] = a[bj][n] * rstd - gw[bj][n] * mr + bw[bj][n]; }
                if (kind < 2) {
                    if (layer == 0) {
                        float ss = 0.f;
#pragma unroll
                        for (int bj = 0; bj < 2; ++bj)
#pragma unroll
                            for (int n = 0; n < 2; ++n) { const f32x4 x = a[bj][n]; ss += (x[0] * x[0] + x[1] * x[1]) + (x[2] * x[2] + x[3] * x[3]); }
                        ss += __shfl_xor(ss, 16); ss += __shfl_xor(ss, 32);
                        const float rs = 1.f / sqrtf(ss * (1.f / 64.f) + LN_EPS);
#pragma unroll
                        for (int bj = 0; bj < 2; ++bj)
#pragma unroll
                            for (int n = 0; n < 2; ++n) a[bj][n] = a[bj][n] * rs * gn[bj][n];
                    }
                    if (lat) {
                        const int t = (jrow - 1) * 256 + rr, prow = t >> 6, pcol = t & 63;
#pragma unroll
                        for (int bj = 0; bj < 2; ++bj) { const int pos = bj ? pcol : prow;
                            const f32x4 c4 = *(const f32x4*)(rope + pos * 16 + 4 * fq), s4 = *(const f32x4*)(rope + 1024 + pos * 16 + 4 * fq);
                            const f32x4 x1 = a[bj][0], x2 = a[bj][1]; a[bj][0] = x1 * c4 - x2 * s4; a[bj][1] = x2 * c4 + x1 * s4; }
                    }
                    if (kind == 0) {
#pragma unroll
                        for (int bj = 0; bj < 2; ++bj)
#pragma unroll
                            for (int n = 0; n < 2; ++n) a[bj][n] = a[bj][n] * QSCALE; }
                }
                if (kind < 3) {
                    bf16* o = O + r * pitch + pn * 256 + wc * 64 + 4 * fq;
#pragma unroll
                    for (int bj = 0; bj < 2; ++bj)
#pragma unroll
                        for (int n = 0; n < 2; ++n) { const f32x4 x = a[bj][n]; u32x2 w; w.x = pg8::cvt_pk_bf16(x[0], x[1]); w.y = pg8::cvt_pk_bf16(x[2], x[3]); *(u32x2*)(o + bj * 32 + n * 16) = w; }
                } else {
                    bf16* o = O + r * P1 + 2304 + (pn - 9) * 128 + wc * 32 + 4 * fq;
#pragma unroll
                    for (int n = 0; n < 2; ++n) { const f32x4 x = a[0][n], g = a[1][n]; u32x2 w;
                        w.x = pg8::cvt_pk_bf16(x[0] * sigmoid_fast(g[0]), x[1] * sigmoid_fast(g[1])); w.y = pg8::cvt_pk_bf16(x[2] * sigmoid_fast(g[2]), x[3] * sigmoid_fast(g[3])); *(u32x2*)(o + n * 16) = w; }
                }
            }
    }
};
struct EpiRes {
    static constexpr bool PERM = false, AFTER_DRAIN = false;
    const Ptrs* p; int layer, gate_off, xin_mode, sp, sc, fold; const float* lng; const float* lnb;
    __device__ __forceinline__ void operator()(const f32x4 (&acc)[2][2][4][2], const pg8::Unit& u, int wr, int wc, int fr, int fq) const {
        const int b = u.pm / 9, j = u.pm % 9; const bool isctx = j == 0; const int mv = isctx ? 8 : b;
        const float* gate = (const float*)(p->ws + WS_MOD) + (size_t)(layer * 9 + mv) * MODW + gate_off;
        float* resbase = isctx ? (float*)(p->ws + WS_XC) + (size_t)(b * CTXL) * D : p->out + (size_t)(b * SEQ + (j - 1) * 256) * D;
        const float* inbase = xin_mode == 0 ? (isctx ? p->ctx + (size_t)(b * CTXL) * D : p->x + (size_t)(b * SEQ + (j - 1) * 256) * D) : resbase;
        const float* gvec = (const float*)(p->ws + WS_GVEC) + (size_t)((fold < 0 ? 0 : fold) * 9 + mv) * 1024;
        const float* stp = (const float*)(p->ws + WS_STATS) + (size_t)(sp < 0 ? 0 : sp) * R * 2; float* stc = (float*)(p->ws + WS_STATS) + (size_t)(sc < 0 ? 0 : sc) * R * 2;
        bf16* An = (bf16*)(p->ws + WS_BUFA);
        const int col0 = u.pn * 256 + wc * 32 + 4 * fq; const size_t grow0 = (size_t)u.pm * 256;
        int lrow = wr * 64 + fr; asm volatile("" : "+v"(lrow));
#pragma unroll
        for (int ai = 0; ai < 2; ++ai) {
            float mu[4], rstd[4], ps[4], pss[4];
#pragma unroll
            for (int m = 0; m < 4; ++m) { ps[m] = 0.f; pss[m] = 0.f; mu[m] = 0.f; rstd[m] = 1.f; if (xin_mode) row_norm(stp, grow0 + ai * 128 + m * 16 + lrow, mu[m], rstd[m]); }
#pragma unroll
            for (int bj = 0; bj < 2; ++bj)
#pragma unroll
                for (int n = 0; n < 2; ++n) { const int c = col0 + bj * 128 + n * 16;
                    const f32x4 gv = *(const f32x4*)(gate + c), gf = fold >= 0 ? *(const f32x4*)(gvec + c) : (f32x4){0.f, 0.f, 0.f, 0.f};
                    const f32x4 gl = xin_mode ? *(const f32x4*)(lng + c) : (f32x4){1.f, 1.f, 1.f, 1.f}, bl = xin_mode ? *(const f32x4*)(lnb + c) : (f32x4){0.f, 0.f, 0.f, 0.f};
#pragma unroll
                    for (int m = 0; m < 4; ++m) { const size_t off = (size_t)(ai * 128 + m * 16 + lrow) * D + c;
                        f32x4 xin;
                        if (xin_mode) { const h16x4 hv = *(const h16x4*)((const _Float16*)(resbase + (size_t)(ai * 128 + m * 16 + lrow) * D) + c); xin = (f32x4){(float)hv[0], (float)hv[1], (float)hv[2], (float)hv[3]}; xin = (xin - mu[m]) * rstd[m] * gl + bl; }
                        else xin = *(const f32x4*)(inbase + off);
                        const f32x4 v = xin * ALPHA + gv * acc[ai][bj][m][n];
                        *(h16x4*)((_Float16*)(resbase + (size_t)(ai * 128 + m * 16 + lrow) * D) + c) = (h16x4){(_Float16)v[0], (_Float16)v[1], (_Float16)v[2], (_Float16)v[3]};
                        ps[m] += (v[0] + v[1]) + (v[2] + v[3]); pss[m] += (v[0] * v[0] + v[1] * v[1]) + (v[2] * v[2] + v[3] * v[3]);
                        if (fold >= 0) { const f32x4 h = v * gf; u32x2 w; w.x = pg8::cvt_pk_bf16(h[0], h[1]); w.y = pg8::cvt_pk_bf16(h[2], h[3]); *(u32x2*)(An + grow0 * D + off) = w; } } }
            if (sc >= 0) {
#pragma unroll
                for (int m = 0; m < 4; ++m) { float a = ps[m], q = pss[m]; a += __shfl_xor(a, 16); a += __shfl_xor(a, 32); q += __shfl_xor(q, 16); q += __shfl_xor(q, 32);
                    if (fq < 2) atomicAdd(stc + 2 * (grow0 + ai * 128 + m * 16 + lrow) + fq, fq ? q : a); } }
            asm volatile("" ::: "memory");
        }
    }
};
struct EpiFfn {
    static constexpr bool PERM = true, AFTER_DRAIN = false;
    const Ptrs* p; int fold, sp;
    __device__ __forceinline__ void operator()(const f32x4 (&acc)[2][2][4][2], const pg8::Unit& u, int wr, int wc, int fr, int fq) const {
        bf16* O = (bf16*)(p->ws + WS_BIG);
        const int h0 = u.pn * 128 + wc * 32 + 8 * fq, mv = (u.pm % 9) == 0 ? 8 : u.pm / 9;
        const float* gwb = (const float*)(p->ws + WS_GWBW) + (fold == 0 ? FOLD_BASE[0] : FOLD_BASE[2]) + (size_t)mv * 2 * FF;
        const float* stp = (const float*)(p->ws + WS_STATS) + (size_t)sp * R * 2;
        int lrow = wr * 64 + fr; asm volatile("" : "+v"(lrow));
        f32x4 gwa[2], bwa[2], gwg[2], bwg[2];
#pragma unroll
        for (int n = 0; n < 2; ++n) { gwa[n] = *(const f32x4*)(gwb + h0 + 4 * n); gwg[n] = *(const f32x4*)(gwb + FF + h0 + 4 * n);
            bwa[n] = *(const f32x4*)(gwb + 9 * 2 * FF + h0 + 4 * n); bwg[n] = *(const f32x4*)(gwb + 9 * 2 * FF + FF + h0 + 4 * n); }
#pragma unroll
        for (int ai = 0; ai < 2; ++ai)
#pragma unroll
            for (int m = 0; m < 4; ++m) { const size_t r = (size_t)u.pm * 256 + ai * 128 + m * 16 + lrow;
                float mu, rstd; row_norm(stp, r, mu, rstd); const float mr = mu * rstd;
                const f32x4 a0 = acc[ai][0][m][0] * rstd - gwa[0] * mr + bwa[0], a1 = acc[ai][0][m][1] * rstd - gwa[1] * mr + bwa[1];
                const f32x4 g0 = acc[ai][1][m][0] * rstd - gwg[0] * mr + bwg[0], g1 = acc[ai][1][m][1] * rstd - gwg[1] * mr + bwg[1]; u32x4 w;
                w.x = pg8::cvt_pk_bf16(silu_fast(g0[0]) * a0[0], silu_fast(g0[1]) * a0[1]); w.y = pg8::cvt_pk_bf16(silu_fast(g0[2]) * a0[2], silu_fast(g0[3]) * a0[3]);
                w.z = pg8::cvt_pk_bf16(silu_fast(g1[0]) * a1[0], silu_fast(g1[1]) * a1[1]); w.w = pg8::cvt_pk_bf16(silu_fast(g1[2]) * a1[2], silu_fast(g1[3]) * a1[3]);
                *(u32x4*)(O + r * FF + h0) = w; }
    }
};
namespace att {
typedef short bf16x8 __attribute__((ext_vector_type(8)));
typedef short s16x4 __attribute__((ext_vector_type(4)));
typedef float f32x16 __attribute__((ext_vector_type(16)));
#define SBAR() __builtin_amdgcn_sched_barrier(0)
constexpr float THR = 8.f;
__device__ __forceinline__ int crow(int r, int hi) { return (r & 3) + 8 * (r >> 2) + 4 * hi; }
__device__ __forceinline__ unsigned cvtpk(float lo, float hi) { unsigned r; asm volatile("v_cvt_pk_bf16_f32 %0, %1, %2" : "=v"(r) : "v"(lo), "v"(hi)); return r; }
__device__ __forceinline__ void partialSM(f32x16& p0, f32x16& p1, float& m_reg, float& mn, float& alpha) {
    float pmax = p0[0];
#pragma unroll
    for (int r = 1; r < 16; ++r) pmax = fmaxf(pmax, p0[r]);
#pragma unroll
    for (int r = 0; r < 16; ++r) pmax = fmaxf(pmax, p1[r]);
    { auto rr = __builtin_amdgcn_permlane32_swap(__float_as_uint(pmax), __float_as_uint(pmax), false, false); pmax = fmaxf(__uint_as_float(rr[0]), __uint_as_float(rr[1])); }
    if (__builtin_expect(__all(pmax - m_reg <= THR), 1)) { mn = m_reg; alpha = 1.f; }
    else { mn = fmaxf(m_reg, pmax); alpha = __builtin_amdgcn_exp2f(m_reg - mn); m_reg = mn; }
#pragma unroll
    for (int r = 0; r < 16; ++r) { p0[r] -= mn; p1[r] -= mn; }
#pragma unroll
    for (int r = 0; r < 16; ++r) p0[r] = __builtin_amdgcn_exp2f(p0[r]);
}
__device__ __forceinline__ void finishSM(f32x16& p0, f32x16& p1, float alpha, float& l_reg, bf16x8& pa0, bf16x8& pa1, bf16x8& pa2, bf16x8& pa3) {
#pragma unroll
    for (int r = 0; r < 16; ++r) p1[r] = __builtin_amdgcn_exp2f(p1[r]);
    float ps = 0;
#pragma unroll
    for (int r = 0; r < 16; ++r) ps += p0[r];
#pragma unroll
    for (int r = 0; r < 16; ++r) ps += p1[r];
    { auto rr = __builtin_amdgcn_permlane32_swap(__float_as_uint(ps), __float_as_uint(ps), false, false); ps = __uint_as_float(rr[0]) + __uint_as_float(rr[1]); }
    l_reg = l_reg * alpha + ps;
#define PK4(P, BASE, OUT) do { unsigned a0 = cvtpk(P[BASE + 0], P[BASE + 1]), a1 = cvtpk(P[BASE + 2], P[BASE + 3]);   \
    unsigned b0 = cvtpk(P[BASE + 4], P[BASE + 5]), b1 = cvtpk(P[BASE + 6], P[BASE + 7]);                              \
    auto r0 = __builtin_amdgcn_permlane32_swap(a0, b0, false, false); auto r1 = __builtin_amdgcn_permlane32_swap(a1, b1, false, false); \
    u32x4 w = {r0[0], r1[0], r0[1], r1[1]}; OUT = __builtin_bit_cast(bf16x8, w); } while (0)
    PK4(p0, 0, pa0); PK4(p0, 8, pa1); PK4(p1, 0, pa2); PK4(p1, 8, pa3);
#undef PK4
}
__device__ __forceinline__ int kswz(int row, int colB) { return row * 128 + (colB ^ (((row >> 1) & 7) << 4)); }
__device__ __forceinline__ void qkt(f32x16& p0, f32x16& p1, LAS const unsigned char* Ks, const bf16x8 (&qr)[4], int r32, int hi) {
    p0 = f32x16{}; p1 = f32x16{};
#pragma unroll
    for (int d0 = 0; d0 < 4; ++d0) { const int cb = d0 * 32 + hi * 16;
        const bf16x8 b0 = *(LAS const bf16x8*)(Ks + kswz(r32, cb));
        const bf16x8 b1 = *(LAS const bf16x8*)(Ks + kswz(32 + r32, cb));
        p0 = __builtin_amdgcn_mfma_f32_32x32x16_bf16(b0, qr[d0], p0, 0, 0, 0);
        p1 = __builtin_amdgcn_mfma_f32_32x32x16_bf16(b1, qr[d0], p1, 0, 0, 0); }
}
template <int DV> __device__ __forceinline__ int v_st(int k, int c) { const int kk = (k & ~0xC) | ((k & 4) << 1) | ((k & 8) >> 1); return ((kk >> 3) * (DV / 32) + (c >> 5)) * 512 + ((kk & 7) * 32 + (c & 31)) * 2; }
__device__ __forceinline__ int v_rd_base(int lane) { return ((lane & 3) << 3) | (((lane >> 2) & 3) << 6) | (((lane >> 4) & 1) << 5) | (((lane >> 5) & 1) << 8); }
template <int DV> constexpr int v_rd_off(int d0, int ks, int half) { return d0 * 512 + ks * (2 * (DV / 32) * 512) + half * ((DV / 32) * 512); }
template <int OFF> __device__ __forceinline__ s16x4 tr_read(int vb) { s16x4 r; asm volatile("ds_read_b64_tr_b16 %0, %1 offset:%2" : "=&v"(r) : "v"(vb), "i"(OFF) : "memory"); return r; }
template <int DV, int D0> __device__ __forceinline__ void pv_one(f32x16& od, int vb, bf16x8 pa0, bf16x8 pa1, bf16x8 pa2, bf16x8 pa3) {
    const s16x4 l0 = tr_read<v_rd_off<DV>(D0, 0, 0)>(vb), h0 = tr_read<v_rd_off<DV>(D0, 0, 1)>(vb), l1 = tr_read<v_rd_off<DV>(D0, 1, 0)>(vb), h1 = tr_read<v_rd_off<DV>(D0, 1, 1)>(vb);
    const s16x4 l2 = tr_read<v_rd_off<DV>(D0, 2, 0)>(vb), h2 = tr_read<v_rd_off<DV>(D0, 2, 1)>(vb), l3 = tr_read<v_rd_off<DV>(D0, 3, 0)>(vb), h3 = tr_read<v_rd_off<DV>(D0, 3, 1)>(vb);
    asm volatile("s_waitcnt lgkmcnt(0)" ::: "memory"); SBAR();
#define PK(L, H) (bf16x8){L[0], L[1], L[2], L[3], H[0], H[1], H[2], H[3]}
    od = __builtin_amdgcn_mfma_f32_32x32x16_bf16(pa0, PK(l0, h0), od, 0, 0, 0);
    od = __builtin_amdgcn_mfma_f32_32x32x16_bf16(pa1, PK(l1, h1), od, 0, 0, 0);
    od = __builtin_amdgcn_mfma_f32_32x32x16_bf16(pa2, PK(l2, h2), od, 0, 0, 0);
    od = __builtin_amdgcn_mfma_f32_32x32x16_bf16(pa3, PK(l3, h3), od, 0, 0, 0);
#undef PK
}
template <int DV> __device__ __forceinline__ void pv_all(f32x16 (&o)[DV / 32], int vb, bf16x8 pa0, bf16x8 pa1, bf16x8 pa2, bf16x8 pa3) {
    pv_one<DV, 0>(o[0], vb, pa0, pa1, pa2, pa3); pv_one<DV, 1>(o[1], vb, pa0, pa1, pa2, pa3);
    if constexpr (DV == 128) { pv_one<DV, 2>(o[2], vb, pa0, pa1, pa2, pa3); pv_one<DV, 3>(o[3], vb, pa0, pa1, pa2, pa3); }
}
template <int NKT, int DV> struct Cfg { static constexpr int KB = 8192, VB = 64 * DV * 2, BUF = NKT * KB + VB, SCR = 2 * BUF, TOTAL = SCR + NWAVES * 256; };
template <int NKT, int DV>
__device__ __forceinline__ void attn_unit(const bf16* Qw, const bf16* const (&Kg)[NKT], const bf16* Vg, int ld, int NT, int kidx, LAS unsigned char* lds, f32x16 (&o)[DV / 32], float& l_out) {
    typedef Cfg<NKT, DV> C;
    const int tid = otid(), wid = tid >> 6, lane = tid & 63, r32 = lane & 31, hi = lane >> 5;
    LAS float* al_l = (LAS float*)(lds + C::SCR) + wid * 64;
    float m_reg = -1e30f, l_reg = 0.f;
#pragma unroll
    for (int d = 0; d < DV / 32; ++d) o[d] = f32x16{};
    bf16x8 qr[4];
#pragma unroll
    for (int d0 = 0; d0 < 4; ++d0) qr[d0] = *(const bf16x8*)(Qw + d0 * 16);
    const int krow = tid >> 3, kch = tid & 7, kst = kswz(krow, kch * 16);
    const int vrow = DV == 64 ? (tid >> 3) : (tid >> 4), vcol = DV == 64 ? (tid & 7) * 8 : (tid & 15) * 8;
    const int vst0 = v_st<DV>(vrow, vcol), vst1 = v_st<DV>(32 + vrow, vcol);
    const int vb0 = (int)(uintptr_t)(lds + NKT * C::KB) + v_rd_base(lane);
    struct { bf16x8 k[NKT]; bf16x8 v[DV / 64]; } sr_[2];
#define SLOAD(i, k0) do { _Pragma("unroll") for (int kt = 0; kt < NKT; ++kt) sr_[i].k[kt] = *(const bf16x8*)(Kg[kt] + (size_t)((k0) + krow) * ld + kch * 8); \
        sr_[i].v[0] = *(const bf16x8*)(Vg + (size_t)((k0) + vrow) * ld + vcol); if constexpr (DV == 128) sr_[i].v[1] = *(const bf16x8*)(Vg + (size_t)((k0) + 32 + vrow) * ld + vcol); } while (0)
#define SWRITE(b, i) do { _Pragma("unroll") for (int kt = 0; kt < NKT; ++kt) *(LAS bf16x8*)(lds + (b) * C::BUF + kt * C::KB + kst) = sr_[i].k[kt]; \
        *(LAS bf16x8*)(lds + (b) * C::BUF + NKT * C::KB + vst0) = sr_[i].v[0]; if constexpr (DV == 128) *(LAS bf16x8*)(lds + (b) * C::BUF + NKT * C::KB + vst1) = sr_[i].v[1]; } while (0)
#define SWAIT() do { if constexpr (NKT + DV / 64 == 2) asm volatile("s_waitcnt vmcnt(2)" ::: "memory"); else asm volatile("s_waitcnt vmcnt(4)" ::: "memory"); } while (0)
#define RESC(a) do { if (__any((a) < 1.f)) { if (hi == 0) al_l[r32] = (a); asm volatile("s_waitcnt lgkmcnt(0)" ::: "memory"); \
        _Pragma("unroll") for (int d = 0; d < DV / 32; ++d) _Pragma("unroll") for (int r = 0; r < 16; ++r) o[d][r] *= al_l[crow(r, hi)]; } } while (0)
    f32x16 pA0, pA1, pB0, pB1; float mnA, mnB, alA, alB; bf16x8 pa0, pa1, pa2, pa3;
    LAS const unsigned char* K0 = lds + kidx * C::KB; LAS const unsigned char* K1 = lds + C::BUF + kidx * C::KB;
    SLOAD(0, 0); asm volatile("s_waitcnt vmcnt(0)" ::: "memory"); SWRITE(0, 0); __syncthreads();
    qkt(pA0, pA1, K0, qr, r32, hi); partialSM(pA0, pA1, m_reg, mnA, alA);
    SLOAD(1, 64); if (2 < NT) SLOAD(0, 128);
    SWAIT(); SWRITE(1, 1); __syncthreads();
    for (int j = 1; j + 1 < NT; j += 2) {
        SBAR(); qkt(pB0, pB1, K1, qr, r32, hi);
        finishSM(pA0, pA1, alA, l_reg, pa0, pa1, pa2, pa3); SBAR();
        SLOAD(1, (j + 2) * 64); SBAR();
        pv_all<DV>(o, vb0, pa0, pa1, pa2, pa3); partialSM(pB0, pB1, m_reg, mnB, alB);
        __syncthreads(); SWAIT(); SWRITE(0, 0);
        RESC(alB); __syncthreads();
        SBAR(); qkt(pA0, pA1, K0, qr, r32, hi);
        finishSM(pB0, pB1, alB, l_reg, pa0, pa1, pa2, pa3); SBAR();
        if (j + 3 < NT) SLOAD(0, (j + 3) * 64); SBAR();
        pv_all<DV>(o, vb0 + C::BUF, pa0, pa1, pa2, pa3); partialSM(pA0, pA1, m_reg, mnA, alA);
        __syncthreads(); SWAIT(); SWRITE(1, 1);
        RESC(alA); __syncthreads();
    }
    SBAR(); qkt(pB0, pB1, K1, qr, r32, hi);
    finishSM(pA0, pA1, alA, l_reg, pa0, pa1, pa2, pa3); SBAR();
    pv_all<DV>(o, vb0, pa0, pa1, pa2, pa3); partialSM(pB0, pB1, m_reg, mnB, alB);
    __syncthreads(); RESC(alB);
    finishSM(pB0, pB1, alB, l_reg, pa0, pa1, pa2, pa3); SBAR();
    pv_all<DV>(o, vb0 + C::BUF, pa0, pa1, pa2, pa3);
    l_out = l_reg;
#undef SLOAD
#undef SWRITE
#undef SWAIT
#undef RESC
}
#undef SBAR
}

__device__ __forceinline__ void attn0_unit(const Ptrs& p, LAS unsigned char* lds, int b, int h, int qb  ) {
    const int tid = otid(), wid = tid >> 6, lane = tid & 63, r32 = lane & 31, hi = lane >> 5, kvh = h / 3;
    const bf16* QKV = (const bf16*)(p.ws + WS_BIG);
    const size_t row0 = (size_t)b * TOK + qb * 256 + wid * 32;
    const bf16* Qw = QKV + (row0 + r32) * P0 + h * 64 + hi * 8;
    const bf16* const Kg[1] = {QKV + (size_t)b * TOK * P0 + 768 + kvh * 64};
    const bf16* Vg = QKV + (size_t)b * TOK * P0 + 1024 + kvh * 64;
    att::f32x16 o[2]; float l;
    att::attn_unit<1, 64>(Qw, Kg, Vg, P0, qb == 0 ? CTXL / 64 : TOK / 64, 0, lds, o, l);
    LAS float* li_l = (LAS float*)(lds + att::Cfg<1, 64>::SCR) + wid * 64;
    if (hi == 0) li_l[r32] = l; asm volatile("s_waitcnt lgkmcnt(0)" ::: "memory");
    int lofs = hi * 4 * D + r32; asm volatile("" : "+v"(lofs));
    bf16* Ob = (bf16*)(p.ws + WS_BUFB) + row0 * D + h * 64 + lofs;
#pragma unroll
    for (int r = 0; r < 16; ++r) { const float il = fast_rcp(li_l[att::crow(r, hi)]);
#pragma unroll
        for (int d0 = 0; d0 < 2; ++d0) Ob[((r & 3) + 8 * (r >> 2)) * D + d0 * 32] = (bf16)f2bf(o[d0][r] * il); }
    __syncthreads();
}
__device__ __forceinline__ void pool_chunk(const Ptrs& p, LAS unsigned char* lds, int chunk) {
    const int tid = otid();
    int rbase, n, t0;
    if (chunk < 256) { const int b = chunk / 32; rbase = b * TOK + CTXL; n = SEQ; t0 = (chunk % 32) * 64; }
    else { const int e = chunk - 256, b = e / 4; rbase = b * TOK; n = CTXL; t0 = (e % 4) * 64; }
    const bf16* U = (const bf16*)(p.ws + WS_BIG) + 1280;
    LAS unsigned short* ub = (LAS unsigned short*)lds;
    LAS float* pooled = (LAS float*)(lds + 80 * 512);
    for (int idx = tid; idx < 80 * 32; idx += NTHR) { const int row = idx >> 5, ch = (idx & 31) * 8, s = t0 - 8 + row;
        u32x4 v = {0u, 0u, 0u, 0u}; if (s >= 0 && s < n) v = *(const u32x4*)(U + (size_t)(rbase + s) * P0 + ch);
        *(LAS u32x4*)(ub + row * 256 + ch) = v; }
    __syncthreads();
    { const int c = tid & 255, g = c >> 6, w = 2 << g, half = tid >> 8;
        for (int tt = half * 32; tt < half * 32 + 32; ++tt) { const int t = t0 + tt, lo = max(t - w / 2, 0), hi = min(t + w - w / 2, n); float s = 0.f;
            for (int j = lo; j < hi; ++j) s += bf2f(ub[(j - t0 + 8) * 256 + c]);
            pooled[tt * 260 + c] = s / (float)(hi - lo) - bf2f(ub[(tt + 8) * 256 + c]); } }
    __syncthreads();
    { const int tb = tid >> 5, db = tid & 31, g = db >> 3, d0 = (db & 7) * 8; const float* W = p.ab_w_pool + (size_t)g * 4096 + d0;
        float acc[4][8];
#pragma unroll
        for (int i = 0; i < 4; ++i)
#pragma unroll
            for (int j = 0; j < 8; ++j) acc[i][j] = 0.f;
#pragma unroll 4
        for (int c = 0; c < 64; ++c) { const f32x4 w0 = *(const f32x4*)(W + c * 64), w1 = *(const f32x4*)(W + c * 64 + 4);
#pragma unroll
            for (int i = 0; i < 4; ++i) { const float pv = pooled[(tb * 4 + i) * 260 + g * 64 + c];
#pragma unroll
                for (int j = 0; j < 4; ++j) { acc[i][j] += pv * w0[j]; acc[i][4 + j] += pv * w1[j]; } } }
        const f32x4 s0 = *(const f32x4*)(p.ab_pool_scale + g * 64 + d0), s1 = *(const f32x4*)(p.ab_pool_scale + g * 64 + d0 + 4);
#pragma unroll
        for (int i = 0; i < 4; ++i) { u32x4 o; o.x = pk2(acc[i][0] * s0[0], acc[i][1] * s0[1]); o.y = pk2(acc[i][2] * s0[2], acc[i][3] * s0[3]); o.z = pk2(acc[i][4] * s1[0], acc[i][5] * s1[1]); o.w = pk2(acc[i][6] * s1[2], acc[i][7] * s1[3]);
            *(u32x4*)((bf16*)(p.ws + WS_BUFB) + (size_t)(rbase + t0 + tb * 4 + i) * D + 768 + g * 64 + d0) = o; } }
    __syncthreads();
}
__device__ __forceinline__ void phase_mix0(const Ptrs& p, LAS unsigned char* lds, int vcu) {
    const int x = vcu >> 5, c = vcu & 31;
    for (int i = 0; i < 3; ++i) { const int uidx = i * 32 + c, pair = x * 4 + uidx / 24, w = uidx % 24; attn0_unit(p, lds, pair >> 2, (pair & 3) * 3 + w / 8, 1 + (w & 7)); }
    if (vcu < 96) attn0_unit(p, lds, vcu / 12, vcu % 12, 0);
    for (int ch = vcu; ch < 288; ch += 256) pool_chunk(p, lds, ch);
}

__device__ __forceinline__ void attn1_unit(const Ptrs& p, LAS unsigned char* lds, int b, int h, int qb  , float lam) {
    typedef att::Cfg<2, 128> C;
    const int tid = otid(), wid = tid >> 6, lane = tid & 63, r32 = lane & 31, hi = lane >> 5, comp = wid >> 2, wq = wid & 3;
    const bf16* QKV = (const bf16*)(p.ws + WS_BIG);
    const size_t row0 = (size_t)b * TOK + CTXL + qb * 128 + wq * 32;
    const bf16* Qw = QKV + (row0 + r32) * P1 + (h * 2 + comp) * 64 + hi * 8;
    const bf16* const Kg[2] = {QKV + (size_t)b * TOK * P1 + 768 + (h * 2) * 64, QKV + (size_t)b * TOK * P1 + 768 + (h * 2 + 1) * 64};
    const bf16* Vg = QKV + (size_t)b * TOK * P1 + 1536 + h * 128;
    att::f32x16 o[4]; float l;
    att::attn_unit<2, 128>(Qw, Kg, Vg, P1, TOK / 64, comp, lds, o, l);
    LAS float* li_l = (LAS float*)(lds + C::SCR) + wid * 64;
    if (hi == 0) li_l[r32] = l; asm volatile("s_waitcnt lgkmcnt(0)" ::: "memory");
    LAS float* X = (LAS float*)(lds + C::TOTAL) + wq * 4096;
#pragma unroll
    for (int r = 0; r < 16; ++r) { const float il = fast_rcp(li_l[att::crow(r, hi)]);
#pragma unroll
        for (int d0 = 0; d0 < 4; ++d0) o[d0][r] *= il; }
    if (comp == 1) {
#pragma unroll
        for (int d0 = 0; d0 < 4; ++d0)
#pragma unroll
            for (int r = 0; r < 16; ++r) X[(d0 * 16 + r) * 64 + lane] = o[d0][r];
    }
    __syncthreads();
    if (comp == 0) {
        int lofs = hi * 4 * D + r32; asm volatile("" : "+v"(lofs));
        bf16* Ob = (bf16*)(p.ws + WS_BUFB) + row0 * D + h * 128 + lofs;
        float gsub[4];
#pragma unroll
        for (int d0 = 0; d0 < 4; ++d0) gsub[d0] = p.subln[d0 * 32 + r32];
#pragma unroll
        for (int r = 0; r < 16; ++r) { float ss = 0.f;
#pragma unroll
            for (int d0 = 0; d0 < 4; ++d0) { o[d0][r] -= lam * X[(d0 * 16 + r) * 64 + lane]; ss += o[d0][r] * o[d0][r]; }
            ss += __shfl_xor(ss, 1); ss += __shfl_xor(ss, 2); ss += __shfl_xor(ss, 4); ss += __shfl_xor(ss, 8); ss += __shfl_xor(ss, 16);
            const float rs = (1.f - LAM_INIT) / sqrtf(ss * (1.f / 128.f) + LN_EPS);
#pragma unroll
            for (int d0 = 0; d0 < 4; ++d0) Ob[((r & 3) + 8 * (r >> 2)) * D + d0 * 32] = (bf16)f2bf(o[d0][r] * rs * gsub[d0]); }
    }
    __syncthreads();
}
__device__ __forceinline__ void conv_chunk(const Ptrs& p, LAS unsigned char* lds, int chunk) {
    const int tid = otid(), wave = tid >> 6, lane = tid & 63, b = chunk / 32, t0 = (chunk % 32) * 64;
    const bf16* Z = (const bf16*)(p.ws + WS_BIG) + (size_t)(b * TOK + CTXL) * P1 + 2304;
    LAS unsigned* zb = (LAS unsigned*)lds;
    LAS float* cv = (LAS float*)(lds + 94 * 512);
    for (int idx = tid; idx < 94 * 32; idx += NTHR) { const int row = idx >> 5, ch = (idx & 31) * 8, s = t0 - 15 + row;
        u32x4 v = {0u, 0u, 0u, 0u}; if (s >= 0 && s < SEQ) v = *(const u32x4*)(Z + (size_t)s * P1 + ch);
        *(LAS u32x4*)((LAS unsigned short*)zb + row * 256 + ch) = v; }
    __syncthreads();
    { const int cp = tid & 127, tg = tid >> 7;
        unsigned zw[46];
#pragma unroll
        for (int i = 0; i < 46; ++i) zw[i] = zb[(tg * 16 + i) * 128 + cp];
        float a0[16], a1[16]; const float b0 = p.conv_b[2 * cp], b1 = p.conv_b[2 * cp + 1];
#pragma unroll
        for (int i = 0; i < 16; ++i) { a0[i] = b0; a1[i] = b1; }
#pragma unroll
        for (int j = 0; j < 31; ++j) { const f32x2 w = *(const f32x2*)(p.conv_w + j * 256 + 2 * cp);
#pragma unroll
            for (int i = 0; i < 16; ++i) { const unsigned z = zw[i + j]; a0[i] += __builtin_bit_cast(float, z << 16) * w.x; a1[i] += __builtin_bit_cast(float, z & 0xffff0000u) * w.y; } }
#pragma unroll
        for (int i = 0; i < 16; ++i) *(LAS f32x2*)(cv + (tg * 16 + i) * 256 + 2 * cp) = (f32x2){a0[i], a1[i]}; }
    __syncthreads();
    { const f32x4 g = *(const f32x4*)(p.conv_ln_g + 4 * lane), bb = *(const f32x4*)(p.conv_ln_b + 4 * lane);
        for (int i = 0; i < 8; ++i) { const int tt = wave * 8 + i; f32x4 v = *(LAS f32x4*)(cv + tt * 256 + 4 * lane);
            const float mean = wave_sum((v[0] + v[1]) + (v[2] + v[3])) * (1.f / 256.f); v = v - mean;
            const float rstd = 1.f / sqrtf(wave_sum((v[0] * v[0] + v[1] * v[1]) + (v[2] * v[2] + v[3] * v[3])) * (1.f / 256.f) + LN_EPS);
            v = v * rstd * g + bb; u32x2 o; o.x = pk2(silu_fast(v[0]), silu_fast(v[1])); o.y = pk2(silu_fast(v[2]), silu_fast(v[3]));
            *(u32x2*)((bf16*)(p.ws + WS_BUFB) + (size_t)(b * TOK + CTXL + t0 + tt) * D + 768 + 4 * lane) = o; } }
    __syncthreads();
}
__device__ __forceinline__ void phase_mix1(const Ptrs& p, LAS unsigned char* lds, int vcu) {
    LAS float* lamp = (LAS float*)(lds + LDS_BYTES - 64);
    if (otid() < 64) { const int l = otid(); const float a = wave_sum(p.lq1[l] * p.lk1[l]), c = wave_sum(p.lq2[l] * p.lk2[l]); if (l == 0) lamp[0] = expf(a) - expf(c) + LAM_INIT; }
    __syncthreads();
    const float lam = lamp[0];
    const int x = vcu >> 5, c = vcu & 31;
    for (int i = 0; i < 3; ++i) { const int uidx = i * 32 + c, grp = x * 6 + uidx / 16; attn1_unit(p, lds, grp / 6, grp % 6, uidx & 15, lam); }
    conv_chunk(p, lds, vcu);
}
#define XB_TMO      128
#define XB_XCNT(j)  (256  + 64 * (j))
#define XB_XSUB(j)  (1280 + 64 * (j))
#define XB_XGEN(j)  (2304 + 64 * (j))
#define XB_TOP      3328
#define XB_TOPGEN   3392
#define XCD_BAR_WORDS 3456
#define XB_SPIN_CAP (1u << 18)

__device__ __forceinline__ unsigned xb_ld(unsigned* p)              { return __hip_atomic_load(p, __ATOMIC_RELAXED, __HIP_MEMORY_SCOPE_AGENT); }
__device__ __forceinline__ unsigned xb_add(unsigned* p, unsigned v) { return __hip_atomic_fetch_add(p, v, __ATOMIC_RELAXED, __HIP_MEMORY_SCOPE_AGENT); }
__device__ __forceinline__ unsigned xb_xcc_id() { return (unsigned)__builtin_amdgcn_s_getreg((3 << 11) | 20) & 0xFu; }
#define XB_SPIN(cond, bar) do { unsigned _sp = 0; while (cond) { __builtin_amdgcn_s_sleep(1); \
    if ((++_sp & 255u) == 0u) { if (xb_ld(&(bar)[XB_TMO])) break; if (_sp > XB_SPIN_CAP) { atomicAdd(&(bar)[XB_TMO], 1u); break; } } } } while (0)

struct XcdBarrier {
    unsigned* bar; unsigned x;
    volatile LAS unsigned* st;
};

__device__ __forceinline__ XcdBarrier xcd_barrier_post(unsigned* bar, volatile LAS unsigned* st) {
    XcdBarrier b; b.bar = bar; b.x = xb_xcc_id(); b.st = st;
    if (otid() == 0) (void)xb_add(&bar[XB_XCNT(b.x)], 1u);
    return b;
}
__device__ __forceinline__ void xcd_barrier_complete(unsigned* bar, unsigned x, unsigned& nloc, unsigned& nx) {
    const unsigned G = gridDim.x * gridDim.y * gridDim.z;
    unsigned sum, cnt, mine, sp = 0u;
    for (;;) {
        sum = 0u; cnt = 0u; mine = 0u;
#pragma unroll
        for (unsigned j = 0; j < 16; ++j) { const unsigned c = xb_ld(&bar[XB_XCNT(j)]); sum += c; cnt += (c > 0u) ? 1u : 0u; mine = (j == x) ? c : mine; }
        if (sum == G) break;
        __builtin_amdgcn_s_sleep(1);
        if ((++sp & 255u) == 0u) { if (xb_ld(&bar[XB_TMO])) break; if (sp > XB_SPIN_CAP) { atomicAdd(&bar[XB_TMO], 1u); break; } }
    }
    nloc = mine > 0u ? mine : 1u; nx = cnt > 0u ? cnt : 1u;
}

__device__ __forceinline__ void xcd_barrier(const XcdBarrier& b) {
    asm volatile("s_waitcnt vmcnt(0)" ::: "memory");
    __syncthreads();
    if (otid() == 0) {
        unsigned* bar = b.bar;
        __builtin_amdgcn_s_waitcnt(0);
        unsigned nloc = b.st[0], nx = b.st[1];
        if (nloc == 0u) { xcd_barrier_complete(bar, b.x, nloc, nx); b.st[0] = nloc; b.st[1] = nx; }
        const unsigned old = xb_add(&bar[XB_XSUB(b.x)], 1u);
        const unsigned gen = old / nloc;
        if (old + 1u == (gen + 1u) * nloc) {
            __builtin_amdgcn_fence(__ATOMIC_RELEASE, "agent");
            asm volatile("s_waitcnt vmcnt(0)" ::: "memory");
            const unsigned og = xb_add(&bar[XB_TOP], 1u);
            const unsigned tg = og / nx;
            if (og + 1u == (tg + 1u) * nx) xb_add(&bar[XB_TOPGEN], 1u);
            else XB_SPIN(xb_ld(&bar[XB_TOPGEN]) == tg, bar);
            __builtin_amdgcn_fence(__ATOMIC_ACQUIRE, "agent");
            xb_add(&bar[XB_XGEN(b.x)], 1u);
            asm volatile("s_waitcnt vmcnt(0)" ::: "memory");
        } else {
            XB_SPIN(xb_ld(&bar[XB_XGEN(b.x)]) == gen, bar);
            __builtin_amdgcn_fence(__ATOMIC_ACQUIRE, "agent");
            asm volatile("s_waitcnt vmcnt(0)" ::: "memory");
        }
    }
    __syncthreads();
}

constexpr int NPHASE = 13;
struct MArgs { Ptrs p; int ph_lo, ph_hi; };
__global__ void __launch_bounds__(NTHR, 2) mega(MArgs a) {
    extern __shared__ __attribute__((aligned(16))) unsigned char lds_raw[];
    LAS unsigned char* lds = (LAS unsigned char*)lds_raw;
    const Ptrs& p = a.p;
    const int tid = otid(), lane = tid & 63, wave = __builtin_amdgcn_readfirstlane(tid >> 6);
    const int G = gridDim.x, bx = blockIdx.x, vcu = (G % 8 == 0) ? (bx % 8) * (G / 8) + bx / 8 : bx;
    const int lo = a.ph_lo, hi = a.ph_hi;
    volatile LAS unsigned* bst = (volatile LAS unsigned*)(lds + LDS_BYTES - 32);
    if (tid == 0) { bst[0] = 0u; bst[1] = 0u; }
    __syncthreads();
    const XcdBarrier xbar = xcd_barrier_post((unsigned*)(p.ws + WS_CTL) + 1024, bst);
#define IN(k) (lo <= (k) && (k) < hi)
#define SEAM(k) do { if (IN(k) && IN((k) + 1)) xcd_barrier(xbar); } while (0)
    const int NGW = G * NWAVES;
#ifndef PROBE_REP
#define PROBE_REP 0
#endif
#define REPS(ph_) ((((PROBE_REP) >> (ph_)) & 1) + 1)
    for (int rep = 0; rep < REPS(0); ++rep) if (IN(0)) { phase_prep(p, lds, vcu, G, tid, wave, lane); __syncthreads(); }
    SEAM(0);
    for (int rep = 0; rep < REPS(1); ++rep) if (IN(1)) { const int t1 = otid(); phase_fold(p, lds, vcu, t1); for (int r = vcu * NWAVES + (t1 >> 6); r < R; r += NGW) row_pass(p, r, t1 & 63, 0, nullptr, nullptr, 0, 0); }
    SEAM(1);
    bf16* BUFA = (bf16*)(p.ws + WS_BUFA); bf16* BUFB = (bf16*)(p.ws + WS_BUFB); bf16* BIG = (bf16*)(p.ws + WS_BIG);
#define PHASE_STEP(S_) do { constexpr int s = (S_); constexpr int ph = s + 2, l = s / 5, k = s % 5; \
        for (int rep = 0; rep < REPS(ph); ++rep) if (IN(ph)) { \
            const int nM = l ? 64 : 72; \
            if (k == 0) { \
                pg8::Gemm g{BUFA, (const bf16*)(p.ws + (l ? WS_WIN1 : WS_WIN0)), 0, 0, D}; \
                TileSched S; if (l == 0) S.init(72, 6, G, bx, 0, 0); else S.init(64, 11, G, bx, 1, 48); \
                if (l == 0) { EpiIn<0> E{&p}; pg8::gemm_phase<EpiIn<0>, TileSched, true, true>(lds, g, S, E); } \
                if (l == 1) { EpiIn<1> E{&p}; pg8::gemm_phase<EpiIn<1>, TileSched, true, true>(lds, g, S, E); } \
            } else if (k == 1) { \
                if (l == 0) phase_mix0(p, lds, vcu); \
                if (l == 1) phase_mix1(p, lds, vcu); \
            } else if (k == 2 || k == 4) { \
                pg8::Gemm g{k == 2 ? BUFB : BIG, k == 2 ? (const bf16*)(p.ws + (l ? WS_WOUT1 : WS_WOUT0)) : (const bf16*)(p.ws + WS_WFOUT) + (size_t)l * D * FF, 0, 0, k == 2 ? D : FF}; \
                TileSched S; S.init(nM, 4, G, bx, l, 0); \
 \
                const int step = 2 * l + (k == 4); \
                EpiRes E{&p, l, k == 2 ? 2048 : 5120, step > 0, step - 1, step < 3 ? step : -1, step < 3 ? step : -1, \
                         step == 2 ? p.ln2_g : (step == 1 ? p.ln1_g : p.ln1_g + D), step == 2 ? p.ln2_b : (step == 1 ? p.ln1_b : p.ln1_b + D)}; \
                pg8::gemm_phase<EpiRes, TileSched, true, true>(lds, g, S, E); \
            } else { \
                pg8::Gemm g{BUFA, (const bf16*)(p.ws + WS_WFIN) + (size_t)l * 2 * FF * D, 0, 0, D}; \
                TileSched S; S.init(nM, 22, G, bx, l, 0); \
                EpiFfn E{&p, l ? 2 : 0, l ? 2 : 0}; \
                pg8::gemm_phase<EpiFfn, TileSched, true, true>(lds, g, S, E); \
            } \
        } \
        SEAM(ph); \
    } while (0)
    PHASE_STEP(0);
    PHASE_STEP(1);
    PHASE_STEP(2);
    PHASE_STEP(3);
    PHASE_STEP(4);
    PHASE_STEP(5);
    PHASE_STEP(6);
    PHASE_STEP(7);
    PHASE_STEP(8);
    PHASE_STEP(9);
#undef PHASE_STEP
    if (IN(12)) { const int t1 = otid();
        for (int i = vcu * NWAVES + (t1 >> 6); i < NB * SEQ; i += NGW) { const int r = (i / SEQ) * TOK + CTXL + i % SEQ; row_pass(p, r, t1 & 63, 1, p.ln2_g + D, p.ln2_b + D, 0, -1); } }
#undef IN
#undef SEAM
}

extern "C" void kernel_launch(void* const* d_in, const int* in_sizes, int n_in, void* d_out, int out_size, void* d_ws, size_t ws_size, hipStream_t stream) {
    if (n_in != 29 || in_sizes[0] != NB * SEQ * D || out_size != NB * SEQ * D || ws_size < WS_END) { fprintf(stderr, "kernel_launch: unexpected shapes (n_in %d, ws %zu)\n", n_in, ws_size); return; }
    static int grid = 0;
    if (grid == 0) {
        int dev = 0, cus = 0, per_cu = 0;
        (void)hipGetDevice(&dev); (void)hipDeviceGetAttribute(&cus, hipDeviceAttributeMultiprocessorCount, dev);
        if (hipFuncSetAttribute((const void*)mega, hipFuncAttributeMaxDynamicSharedMemorySize, LDS_BYTES) != hipSuccess) { fprintf(stderr, "kernel_launch: hipFuncSetAttribute failed\n"); grid = -1; return; }
        (void)hipOccupancyMaxActiveBlocksPerMultiprocessor(&per_cu, (const void*)mega, NTHR, LDS_BYTES);
        if (per_cu < 1) { fprintf(stderr, "kernel_launch: occupancy query says %d blocks per CU\n", per_cu); grid = -1; return; }
        grid = cus;
        fprintf(stderr, "kernel_launch: %d CUs, occupancy %d per CU, grid %d\n", cus, per_cu, grid);
    }
    if (grid < 0) return;
    MArgs a; memset(&a, 0, sizeof(a));
    const float** f = (const float**)&a.p;
    for (int i = 0; i < 29; ++i) f[i] = (const float*)d_in[i];
    a.p.out = (float*)d_out; a.p.ws = (unsigned char*)d_ws;
    {
        int ph = 0, e = NPHASE; a.ph_lo = ph; a.ph_hi = e;
        if (hipMemsetAsync((char*)d_ws + WS_CTL, 0, 64 * 1024, stream) != hipSuccess) fprintf(stderr, "kernel_launch: memset failed\n");
        void* args[] = {&a};
        hipError_t err = hipLaunchCooperativeKernel((const void*)mega, dim3(grid), dim3(NTHR), args, LDS_BYTES, stream);
        if (err != hipSuccess) fprintf(stderr, "kernel_launch: cooperative launch failed: %s (grid %d)\n", hipGetErrorString(err), grid);
    }
}
```
